# Optimizing an MI355X kernel written in HIP

```python
import jax, jax.numpy as jnp
from jax import lax
import numpy as np

D_MODEL = 2048
BATCH = 2
SEQ = 4096
DEPTH = 1

CTX_LEN = 256
GRID_W = 64
D_MIX = D_MODEL
D_LRU = D_MIX // 2
LRU_BLOCKS = 8
LRU_BS = D_LRU // LRU_BLOCKS
CONV_W = 4
LRU_C = 8.0
D_MV = D_MIX - D_LRU
M_HEADS = 8
M_DV = D_MV // M_HEADS
M_DK = M_DV // 2
D_MQK = M_HEADS * M_DK
CHUNK = 128
D_FF = ((8 * D_MODEL // 3 + 255) // 256) * 256
N_MOD = 9
EPS = 1e-6
HALF = 0.5
IN_WIDTHS = (D_LRU, D_LRU, D_MQK, D_MQK, D_MV, D_MV, 4 * M_HEADS)
D_IN = sum(IN_WIDTHS)
SPLITS = [int(s) for s in np.cumsum(IN_WIDTHS)[:-1]]

kernel_name = "hybrid_rglru_mlstm_macaron_dit_block"


def rmsnorm(x, g):
    xf = x.astype(jnp.float32)
    y = xf * lax.rsqrt(jnp.mean(xf * xf, axis=-1, keepdims=True) + EPS)
    return (y * g.astype(jnp.float32)).astype(x.dtype)


def modulate(h, shift, scale):
    return h * (1 + scale) + shift


def swiglu(h, w_up, w_down):
    gate, up = jnp.split(h @ w_up, 2, axis=-1)
    return (jax.nn.silu(gate) * up) @ w_down


def centred_conv(x, w, b):
    T = x.shape[1]
    lo = CONV_W // 2
    xp = jnp.pad(x, ((0, 0), (lo, CONV_W - 1 - lo), (0, 0)))
    return b + sum(xp[:, k:k + T] * w[k] for k in range(CONV_W))


def linear_scan(a, bx, h0):
    bx = bx.at[:, 0].add(a[:, 0] * h0)

    def combine(l, r):
        al, bl = l
        ar, br = r
        return al * ar, ar * bl + br

    _, h = lax.associative_scan(combine, (a, bx), axis=1)
    return h


def rglru_dir(xc, w_r, b_r, w_i, b_i, lam, h0):
    B, T, _ = xc.shape
    xb = xc.reshape(B, T, LRU_BLOCKS, LRU_BS)
    r = jax.nn.sigmoid(jnp.einsum('btnc,ncd->btnd', xb, w_r).reshape(B, T, D_LRU) + b_r)
    i = jax.nn.sigmoid(jnp.einsum('btnc,ncd->btnd', xb, w_i).reshape(B, T, D_LRU) + b_i)
    log_a = -LRU_C * r * jax.nn.softplus(-lam.astype(jnp.float32))
    a = jnp.exp(log_a)
    mult = jnp.sqrt(-jnp.expm1(2.0 * log_a))
    return linear_scan(a, mult * i * xc, h0)


def rglru_bidir(u_lat, u_ctx, conv_w, conv_b, w_r, b_r, w_i, b_i, lam):
    f32 = jnp.float32
    xl = centred_conv(u_lat.astype(f32), conv_w, conv_b)
    xc = centred_conv(u_ctx.astype(f32), conv_w, conv_b)
    z = jnp.zeros((xc.shape[0], D_LRU), f32)

    def run(d, seq, h0):
        return rglru_dir(seq, w_r[d], b_r[d], w_i[d], b_i[d], lam[d], h0)

    hc_f = run(0, xc, z)
    hl_f = run(0, xl, hc_f[:, -1])
    hc_b = run(1, xc[:, ::-1], z)
    hl_b = run(1, xl[:, ::-1], hc_b[:, -1])
    return hl_f + hl_b[:, ::-1], hc_f + hc_b[:, ::-1]


def mlstm_dir(q, k, v, ig, fg, state0):
    B, H, T, DK = q.shape
    DV = v.shape[-1]
    nc = T // CHUNK

    def chunks(t):
        t = t.reshape((B, H, nc, CHUNK) + t.shape[3:])
        return jnp.moveaxis(t, 2, 0)

    log_f = jax.nn.log_sigmoid(fg)
    lower = jnp.tril(jnp.ones((CHUNK, CHUNK), dtype=bool))

    def step(state, xs):
        C, n, m = state
        qc, kc, vc, ic, lfc = xs
        bcum = jnp.cumsum(lfc, axis=-1)
        dmat = bcum[..., :, None] - bcum[..., None, :] + ic[..., None, :]
        dmat = jnp.where(lower, dmat, -jnp.inf)
        inter = bcum + m[..., None]
        m_row = jnp.maximum(inter, jnp.max(dmat, axis=-1))
        w = jnp.einsum('bhtk,bhsk->bhts', qc, kc) * jnp.exp(dmat - m_row[..., None])
        s_inter = jnp.exp(inter - m_row)
        num = s_inter[..., None] * jnp.einsum('bhvk,bhtk->bhtv', C, qc) + jnp.einsum('bhts,bhsv->bhtv', w, vc)
        den = s_inter * jnp.einsum('bhk,bhtk->bht', n, qc) + jnp.sum(w, axis=-1)
        h = num / jnp.maximum(jnp.abs(den), jnp.exp(-m_row))[..., None]
        b_last = bcum[..., -1]
        g = b_last[..., None] - bcum + ic
        m_new = jnp.maximum(b_last + m, jnp.max(g, axis=-1))
        decay = jnp.exp(b_last + m - m_new)
        wg = jnp.exp(g - m_new[..., None])
        C_new = decay[..., None, None] * C + jnp.einsum('bhs,bhsv,bhsk->bhvk', wg, vc, kc)
        n_new = decay[..., None] * n + jnp.einsum('bhs,bhsk->bhk', wg, kc)
        return (C_new, n_new, m_new), h

    state, hs = lax.scan(step, state0, (chunks(q), chunks(k), chunks(v), chunks(ig), chunks(log_f)))
    h = jnp.moveaxis(hs, 0, 2).reshape(B, H, T, DV)
    return h, state


def mlstm_prep(q, k, v, gt):
    f32 = jnp.float32
    B, T, _ = q.shape

    def heads(t, d):
        return t.astype(f32).reshape(B, T, M_HEADS, d).transpose(0, 2, 1, 3)

    gates = gt.astype(f32).reshape(B, T, 4, M_HEADS).transpose(2, 0, 3, 1)
    return heads(q, M_DK), heads(k, M_DK) * (M_DK ** -0.5), heads(v, M_DV), gates


def mlstm_bidir(lat, ctx_in):
    ql, kl, vl, gl = lat
    qc, kc, vc, gc = ctx_in
    B = qc.shape[0]
    f32 = jnp.float32
    zero = (jnp.zeros((B, M_HEADS, M_DV, M_DK), f32), jnp.zeros((B, M_HEADS, M_DK), f32),
            jnp.zeros((B, M_HEADS), f32))

    def fl(t):
        return jnp.flip(t, axis=2)

    hc_f, st_f = mlstm_dir(qc, kc, vc, gc[0], gc[1], zero)
    hl_f, _ = mlstm_dir(ql, kl, vl, gl[0], gl[1], st_f)
    hc_b, st_b = mlstm_dir(fl(qc), fl(kc), fl(vc), jnp.flip(gc[2], -1), jnp.flip(gc[3], -1), zero)
    hl_b, _ = mlstm_dir(fl(ql), fl(kl), fl(vl), jnp.flip(gl[2], -1), jnp.flip(gl[3], -1), st_b)
    return hl_f + fl(hl_b), hc_f + fl(hc_b)


def mlstm_headnorm(hh, gain):
    B, H, T, DV = hh.shape
    hh = hh * lax.rsqrt(jnp.mean(hh * hh, axis=-1, keepdims=True) + EPS)
    return hh.transpose(0, 2, 1, 3).reshape(B, T, H * DV) * gain.astype(jnp.float32)


def to_colmajor(t, rows):
    B, T, F = t.shape
    return t.reshape(B, rows, GRID_W, F).transpose(0, 2, 1, 3).reshape(B, T, F)


def from_colmajor(t, rows):
    B, T, F = t.shape
    return t.reshape(B, GRID_W, rows, F).transpose(0, 2, 1, 3).reshape(B, T, F)


def token_mix(h, hc, rows, is_last, w_in, b_mgate, lru_conv_w, lru_conv_b, lru_w_r, lru_b_r,
              lru_w_i, lru_b_i, lru_lam, mlstm_norm, w_out):
    lx, lg, q, k, v, o, gt = jnp.split(h @ w_in, SPLITS, axis=-1)
    lxc, lgc, qc, kc, vc, oc, gtc = jnp.split(hc @ w_in, SPLITS, axis=-1)
    f32 = jnp.float32
    rl, rc = rglru_bidir(lx, lxc, lru_conv_w, lru_conv_b, lru_w_r, lru_b_r, lru_w_i, lru_b_i, lru_lam)
    lru_lat = jax.nn.gelu(lg.astype(f32)) * rl
    cm = lambda t: to_colmajor(t, rows)
    ml, mc = mlstm_bidir(mlstm_prep(cm(q), cm(k), cm(v), cm(gt) + b_mgate),
                         mlstm_prep(qc, kc, vc, gtc + b_mgate))
    mls_lat = from_colmajor(mlstm_headnorm(ml, mlstm_norm), rows) * jax.nn.sigmoid(o.astype(f32))
    y = jnp.concatenate([lru_lat, mls_lat], axis=-1).astype(h.dtype) @ w_out
    if is_last:
        return y, None
    lru_c = jax.nn.gelu(lgc.astype(f32)) * rc
    mls_c = mlstm_headnorm(mc, mlstm_norm) * jax.nn.sigmoid(oc.astype(f32))
    yc = jnp.concatenate([lru_c, mls_c], axis=-1).astype(hc.dtype) @ w_out
    return y, yc


def layer(x, ctx, mod, mod_c, rows, is_last, ffn1_norm, ffn1_w_up, ffn1_w_down, mix_norm, w_in,
          b_mgate, lru_conv_w, lru_conv_b, lru_w_r, lru_b_r, lru_w_i, lru_b_i, lru_lam, mlstm_norm,
          w_out, ffn2_norm, ffn2_w_up, ffn2_w_down):
    sh1, sc1, g1, sh2, sc2, g2, sh3, sc3, g3 = jnp.split(mod, N_MOD, axis=-1)
    csh1, csc1, cg1, csh2, csc2, cg2, csh3, csc3, cg3 = jnp.split(mod_c, N_MOD, axis=-1)
    x = x + HALF * g1 * swiglu(modulate(rmsnorm(x, ffn1_norm), sh1, sc1), ffn1_w_up, ffn1_w_down)
    ctx = ctx + HALF * cg1 * swiglu(modulate(rmsnorm(ctx, ffn1_norm), csh1, csc1), ffn1_w_up, ffn1_w_down)
    h = modulate(rmsnorm(x, mix_norm), sh2, sc2)
    hc = modulate(rmsnorm(ctx, mix_norm), csh2, csc2)
    y, yc = token_mix(h, hc, rows, is_last, w_in, b_mgate, lru_conv_w, lru_conv_b, lru_w_r, lru_b_r,
                      lru_w_i, lru_b_i, lru_lam, mlstm_norm, w_out)
    x = x + g2 * y
    x = x + HALF * g3 * swiglu(modulate(rmsnorm(x, ffn2_norm), sh3, sc3), ffn2_w_up, ffn2_w_down)
    if not is_last:
        ctx = ctx + cg2 * yc
        ctx = ctx + HALF * cg3 * swiglu(modulate(rmsnorm(ctx, ffn2_norm), csh3, csc3), ffn2_w_up, ffn2_w_down)
    return x, ctx


def setup_inputs(seed: int = 0) -> dict:
    key = jax.random.key(seed)
    ks = jax.random.split(key, 32)
    f32 = jnp.float32

    def nrm(k, shape, s):
        return jax.random.normal(k, shape, f32) * s

    x = nrm(ks[0], (BATCH, SEQ, D_MODEL), 1.0)
    c = nrm(ks[1], (BATCH, D_MODEL), 1.0)
    ctx = nrm(ks[2], (BATCH, CTX_LEN, D_MODEL), 1.0)
    c_ctx = nrm(ks[3], (D_MODEL,), 1.0)
    ada_w = nrm(ks[4], (DEPTH, D_MODEL, N_MOD * D_MODEL), 0.5 * D_MODEL ** -0.5)
    ada_b = nrm(ks[5], (DEPTH, N_MOD * D_MODEL), 0.01)
    ffn1_norm = 1.0 + nrm(ks[6], (DEPTH, D_MODEL), 0.01)
    ffn1_w_up = nrm(ks[7], (DEPTH, D_MODEL, 2 * D_FF), D_MODEL ** -0.5)
    ffn1_w_down = nrm(ks[8], (DEPTH, D_FF, D_MODEL), D_FF ** -0.5)
    mix_norm = 1.0 + nrm(ks[9], (DEPTH, D_MODEL), 0.01)
    w_in = nrm(ks[10], (DEPTH, D_MODEL, D_IN), D_MODEL ** -0.5)
    f_off = jnp.stack([jnp.zeros((M_HEADS,), f32), jnp.linspace(3.0, 6.0, M_HEADS, dtype=f32)])
    b_mgate = (nrm(ks[11], (DEPTH, 2, 2, M_HEADS), 0.1) + f_off).reshape(DEPTH, 4 * M_HEADS)
    lru_conv_w = nrm(ks[12], (DEPTH, CONV_W, D_LRU), CONV_W ** -0.5)
    lru_conv_b = nrm(ks[13], (DEPTH, D_LRU), 0.01)
    lru_w_r = nrm(ks[14], (DEPTH, 2, LRU_BLOCKS, LRU_BS, LRU_BS), LRU_BS ** -0.5)
    lru_b_r = nrm(ks[15], (DEPTH, 2, D_LRU), 0.01)
    lru_w_i = nrm(ks[16], (DEPTH, 2, LRU_BLOCKS, LRU_BS, LRU_BS), LRU_BS ** -0.5)
    lru_b_i = nrm(ks[17], (DEPTH, 2, D_LRU), 0.01)
    a0 = jax.random.uniform(ks[18], (DEPTH, 2, D_LRU), f32, minval=0.9, maxval=0.999)
    lru_lam = jnp.log(a0) - jnp.log1p(-a0)
    mlstm_norm = 1.0 + nrm(ks[19], (DEPTH, D_MV), 0.01)
    w_out = nrm(ks[20], (DEPTH, D_MIX, D_MODEL), D_MIX ** -0.5)
    ffn2_norm = 1.0 + nrm(ks[21], (DEPTH, D_MODEL), 0.01)
    ffn2_w_up = nrm(ks[22], (DEPTH, D_MODEL, 2 * D_FF), D_MODEL ** -0.5)
    ffn2_w_down = nrm(ks[23], (DEPTH, D_FF, D_MODEL), D_FF ** -0.5)
    final_norm = 1.0 + nrm(ks[24], (D_MODEL,), 0.01)
    return {"x": x, "c": c, "ctx": ctx, "c_ctx": c_ctx, "ada_w": ada_w, "ada_b": ada_b,
            "ffn1_norm": ffn1_norm, "ffn1_w_up": ffn1_w_up, "ffn1_w_down": ffn1_w_down,
            "mix_norm": mix_norm, "w_in": w_in, "b_mgate": b_mgate, "lru_conv_w": lru_conv_w,
            "lru_conv_b": lru_conv_b, "lru_w_r": lru_w_r, "lru_b_r": lru_b_r, "lru_w_i": lru_w_i,
            "lru_b_i": lru_b_i, "lru_lam": lru_lam, "mlstm_norm": mlstm_norm, "w_out": w_out,
            "ffn2_norm": ffn2_norm, "ffn2_w_up": ffn2_w_up, "ffn2_w_down": ffn2_w_down,
            "final_norm": final_norm}


def reference(x, c, ctx, c_ctx, ada_w, ada_b, ffn1_norm, ffn1_w_up, ffn1_w_down, mix_norm, w_in,
              b_mgate, lru_conv_w, lru_conv_b, lru_w_r, lru_b_r, lru_w_i, lru_b_i, lru_lam,
              mlstm_norm, w_out, ffn2_norm, ffn2_w_up, ffn2_w_down, final_norm):
    rows = x.shape[1] // GRID_W
    sc = jax.nn.silu(c)
    sc_ctx = jax.nn.silu(c_ctx)
    for l in range(DEPTH):
        mod = (sc @ ada_w[l] + ada_b[l])[:, None, :]
        mod_c = (sc_ctx @ ada_w[l] + ada_b[l])[None, None, :]
        x, ctx = layer(x, ctx, mod, mod_c, rows, l == DEPTH - 1, ffn1_norm[l], ffn1_w_up[l],
                       ffn1_w_down[l], mix_norm[l], w_in[l], b_mgate[l], lru_conv_w[l], lru_conv_b[l],
                       lru_w_r[l], lru_b_r[l], lru_w_i[l], lru_b_i[l], lru_lam[l], mlstm_norm[l],
                       w_out[l], ffn2_norm[l], ffn2_w_up[l], ffn2_w_down[l])
    return rmsnorm(x, final_norm)
```

```cpp
#include <hip/hip_runtime.h>
#include <hip/hip_cooperative_groups.h>
#include <cstdio>
#include <cstdint>
namespace cg = cooperative_groups;
#define STAGE 99
namespace pg8 {
#define PG8_LAS __attribute__((address_space(3)))
typedef unsigned short bf16_t;
typedef short bf16x8 __attribute__((ext_vector_type(8)));
typedef float f32x4 __attribute__((ext_vector_type(4)));
typedef unsigned u32x4 __attribute__((ext_vector_type(4)));
constexpr int BM = 256, BK = 64, HALF = 128, HTB = HALF * BK * 2  , STAGE_BYTES = 8 * HTB, NXCD = 8, WGM = 8;

__host__ __device__ __forceinline__ int lds_byte(int r, int c) { const int st = (r >> 4) * 2 + (c >> 5), rr = r & 15, cc = c & 31, ob = rr * 64 + cc * 2; return st * 1024 + (ob ^ (((ob >> 9) & 1) << 5)); }
__host__ __device__ __forceinline__ void stage_rc(int b, int& R, int& C) { const int st = b / 1024, sb = b % 1024, swz = sb ^ (((sb >> 9) & 1) << 5); R = (st >> 1) * 16 + swz / 64; C = (st & 1) * 32 + (swz % 64) / 2; }
__host__ __device__ __forceinline__ int perm32(int rho) { const int n = rho >> 4, i = rho & 15; return 8 * (i >> 2) + 4 * n + (i & 3); }

struct Unit { int pm, pn; };
struct Gemm { const bf16_t* A; const bf16_t* Bt; int M, N, K; };

struct StaticOrder {
    int nM, nN, nwg, G, c;
    __host__ __device__ void init(int M, int N, int G_, int c_) { nM = M / BM; nN = N / BM; nwg = nM * nN; G = G_; c = c_; }
    __host__ __device__ bool next(int i, Unit& u) const {
        const long L = (long)i * G + c; if (L >= nwg) return false;
        int wgid = (int)L; { const int q = nwg / NXCD, r = nwg % NXCD, xcd = wgid % NXCD, off = wgid / NXCD; wgid = (xcd < r ? xcd * (q + 1) : r * (q + 1) + (xcd - r) * q) + off; }
        const int nig = WGM * nN, gid = wgid / nig, fm = gid * WGM, gsz = (nM - fm) < WGM ? (nM - fm) : WGM;
        u.pm = fm + ((wgid % nig) % gsz); u.pn = (wgid % nig) / gsz; return true;
    }
    __device__ __forceinline__ void a_ready(const Unit&) const {}
    __device__ __forceinline__ void done(const Unit&) const {}
};

__device__ __forceinline__ unsigned cvt_pk_bf16(float lo, float hi) { unsigned r; asm volatile("v_cvt_pk_bf16_f32 %0, %1, %2" : "=v"(r) : "v"(lo), "v"(hi)); return r; }
typedef float f32x2 __attribute__((ext_vector_type(2)));
__device__ __forceinline__ f32x2 gelu_pk(f32x2 v) {
    const f32x2 av = __builtin_elementwise_abs(v), d = av * 0.2316418882f + 1.0f;
    f32x2 t; t.x = __builtin_amdgcn_rcpf(d.x); t.y = __builtin_amdgcn_rcpf(d.y);
    f32x2 q = t * 0.5307027145f + (-0.7265760135f); q = q * t + 0.7107068705f; q = q * t + (-0.142248368f); q = q * t + 0.127414796f; q = q * t;
    const f32x2 s = (v * v) * (-0.72134752044f);
    f32x2 e; e.x = __builtin_amdgcn_exp2f(s.x); e.y = __builtin_amdgcn_exp2f(s.y);
    const f32x2 m = v * (q * e), r = v - m;
    f32x2 o; o.x = v.x < 0.f ? m.x : r.x; o.y = v.y < 0.f ? m.y : r.y; return o;
}

template <class Epi, class Sched, bool ALIGN_EPI = false, bool SP2 = false>
__device__ __forceinline__ void gemm_phase(PG8_LAS unsigned char* lds, const Gemm g, const Sched& S, const Epi& E) {
    const int tid = threadIdx.x, wid = __builtin_amdgcn_readfirstlane(tid >> 6), lane = tid & 63, wr = wid >> 2, wc = wid & 3, fr = lane & 15, fq = lane >> 4;
    const int K = g.K, nt = K / BK;
    unsigned voffA[2], voffB[2];
#pragma unroll
    for (int i = 0; i < 2; ++i) { int R, C; stage_rc(tid * 16 + i * 8192, R, C); const int Rb = Epi::PERM ? ((R & ~31) + perm32(R & 31)) : R;
        voffA[i] = (unsigned)(R * K + C) * 2u; voffB[i] = (unsigned)(Rb * K + C) * 2u; }
    const size_t kstep = (size_t)(BK * 2);
    const size_t hstep = (size_t)HALF * K * 2;
    const size_t tstep = 2 * hstep;
    const unsigned ldsw = (unsigned)wid * 1024u;
    const int aoff = lds_byte(wr * 64 + fr, fq * 8), boff = lds_byte(wc * 32 + fr, fq * 8);
#define PG8_SA(b, h) (((b) * 2 + (h)) * HTB)
#define PG8_SB(b, h) ((4 + (b) * 2 + (h)) * HTB)
#define PG8_STAGE(bufoff, gbase, voff) do { _Pragma("unroll") for (int _i = 0; _i < 2; ++_i) \
        __builtin_amdgcn_global_load_lds((const unsigned*)((const char*)(gbase) + (voff)[_i]), (PG8_LAS unsigned*)(lds + (bufoff) + ldsw + _i * 8192), 16, 0, 0); } while (0)
#define PG8_LDA(dst, b, h) do { _Pragma("unroll") for (int m = 0; m < 4; ++m) _Pragma("unroll") for (int k = 0; k < 2; ++k) dst[m][k] = *(const PG8_LAS bf16x8*)(lds + PG8_SA(b, h) + aoff + m * 2048 + k * 1024); } while (0)
#define PG8_LDB(dst, b, h) do { _Pragma("unroll") for (int n = 0; n < 2; ++n) _Pragma("unroll") for (int k = 0; k < 2; ++k) dst[n][k] = *(const PG8_LAS bf16x8*)(lds + PG8_SB(b, h) + boff + n * 2048 + k * 1024); } while (0)
#define PG8_MMA(ai, bj, At, Bt) do { __builtin_amdgcn_s_setprio(1); _Pragma("unroll") for (int m = 0; m < 4; ++m) _Pragma("unroll") for (int n = 0; n < 2; ++n) _Pragma("unroll") for (int k = 0; k < 2; ++k) \
        acc[ai][bj][m][n] = __builtin_amdgcn_mfma_f32_16x16x32_bf16(Bt[n][k], At[m][k], acc[ai][bj][m][n], 0, 0, 0); __builtin_amdgcn_s_setprio(0); } while (0)
#define PG8_WAIT_V(n) asm volatile("s_waitcnt vmcnt(" #n ")" ::: "memory")
#define PG8_WAIT_L(n) asm volatile("s_waitcnt lgkmcnt(" #n ")" ::: "memory")
#define PG8_BAR __builtin_amdgcn_s_barrier()
#define PG8_SCHED __builtin_amdgcn_sched_barrier(0)
    Unit cur, nxt; int ui = 0;
    if (!S.next(0, cur)) return;
    f32x4 acc[2][2][4][2];
#pragma unroll
    for (int a = 0; a < 2; ++a)
#pragma unroll
        for (int b = 0; b < 2; ++b)
#pragma unroll
            for (int m = 0; m < 4; ++m)
#pragma unroll
                for (int n = 0; n < 2; ++n) acc[a][b][m][n] = (f32x4){0.f, 0.f, 0.f, 0.f};
    bf16x8 At[4][2], B0[2][2], B1[2][2];
    const char* cA = (const char*)g.A + (size_t)cur.pm * tstep; const char* cB = (const char*)g.Bt + (size_t)cur.pn * tstep;
    S.a_ready(cur);
    if constexpr (SP2) {
        PG8_STAGE(PG8_SB(0, 0), cB, voffB); PG8_STAGE(PG8_SB(0, 1), cB + hstep, voffB); PG8_STAGE(PG8_SA(0, 0), cA, voffA); PG8_STAGE(PG8_SA(0, 1), cA + hstep, voffA);
        if (wr == 1) PG8_BAR;
        PG8_WAIT_V(2); PG8_BAR;
        PG8_STAGE(PG8_SB(1, 0), cB + kstep, voffB); PG8_STAGE(PG8_SA(1, 0), cA + kstep, voffA); PG8_STAGE(PG8_SB(1, 1), cB + hstep + kstep, voffB);
        PG8_WAIT_V(6); PG8_BAR;
    } else {
        PG8_STAGE(PG8_SB(0, 0), cB, voffB); PG8_STAGE(PG8_SA(0, 0), cA, voffA); PG8_STAGE(PG8_SB(0, 1), cB + hstep, voffB); PG8_STAGE(PG8_SA(0, 1), cA + hstep, voffA);
        if (wr == 1) PG8_BAR;
        PG8_WAIT_V(4); PG8_BAR;
        PG8_STAGE(PG8_SB(1, 0), cB + kstep, voffB); PG8_STAGE(PG8_SA(1, 0), cA + kstep, voffA); PG8_STAGE(PG8_SB(1, 1), cB + hstep + kstep, voffB);
        PG8_WAIT_V(6); PG8_BAR;
    }
    for (;;) {
        const bool has_next = S.next(ui + 1, nxt);
        const char* nA = has_next ? (const char*)g.A + (size_t)nxt.pm * tstep : cA; const char* nB = has_next ? (const char*)g.Bt + (size_t)nxt.pn * tstep : cB;
        for (int t = 0; t < nt; t += 2) {
            const bool last = (t == nt - 2);
            const char* a1 = cA + (size_t)(t + 1) * kstep;
            const char* a2 = last ? nA : cA + (size_t)(t + 2) * kstep; const char* b2 = last ? nB : cB + (size_t)(t + 2) * kstep;
            const char* a3 = a2 + kstep; const char* b3 = b2 + kstep;
            if (last && has_next) S.a_ready(nxt);
            if constexpr (SP2) {
            PG8_LDB(B0, 0, 0); PG8_LDB(B1, 0, 1); PG8_SCHED; PG8_LDA(At, 0, 0); PG8_STAGE(PG8_SA(1, 1), a1 + hstep, voffA);
            PG8_WAIT_V(8); PG8_WAIT_L(0); PG8_BAR; PG8_MMA(0, 0, At, B0); PG8_MMA(0, 1, At, B1); PG8_BAR; PG8_SCHED;
            PG8_LDA(At, 0, 1); PG8_STAGE(PG8_SB(0, 0), b2, voffB); PG8_STAGE(PG8_SB(0, 1), b2 + hstep, voffB); PG8_STAGE(PG8_SA(0, 0), a2, voffA);
            PG8_WAIT_V(8); PG8_WAIT_L(0); PG8_BAR; PG8_MMA(1, 0, At, B0); PG8_MMA(1, 1, At, B1); PG8_BAR; PG8_SCHED;
            PG8_LDB(B0, 1, 0); PG8_LDB(B1, 1, 1); PG8_SCHED; PG8_LDA(At, 1, 0); PG8_STAGE(PG8_SA(0, 1), a2 + hstep, voffA);
            PG8_WAIT_V(8); PG8_WAIT_L(0); PG8_BAR; PG8_MMA(0, 0, At, B0); PG8_MMA(0, 1, At, B1); PG8_BAR; PG8_SCHED;
            PG8_LDA(At, 1, 1); PG8_STAGE(PG8_SB(1, 0), b3, voffB); PG8_STAGE(PG8_SB(1, 1), b3 + hstep, voffB); PG8_STAGE(PG8_SA(1, 0), a3, voffA);
            PG8_WAIT_V(8); PG8_WAIT_L(0); PG8_BAR; PG8_MMA(1, 0, At, B0); PG8_MMA(1, 1, At, B1); PG8_BAR; PG8_SCHED;
            } else {
            PG8_LDB(B0, 0, 0); PG8_SCHED; PG8_LDA(At, 0, 0); PG8_STAGE(PG8_SA(1, 1), a1 + hstep, voffA);
            PG8_WAIT_L(8); PG8_BAR; PG8_WAIT_L(0); PG8_MMA(0, 0, At, B0); PG8_BAR; PG8_SCHED;
            PG8_LDB(B1, 0, 1); PG8_STAGE(PG8_SB(0, 0), b2, voffB);
            PG8_BAR; PG8_WAIT_L(0); PG8_MMA(0, 1, At, B1); PG8_BAR;
            PG8_LDA(At, 0, 1); PG8_STAGE(PG8_SA(0, 0), a2, voffA);
            PG8_BAR; PG8_WAIT_L(0); PG8_MMA(1, 0, At, B0); PG8_BAR; PG8_SCHED;
            PG8_STAGE(PG8_SB(0, 1), b2 + hstep, voffB);
            PG8_WAIT_V(6); PG8_BAR; PG8_MMA(1, 1, At, B1); PG8_BAR;
            PG8_LDB(B0, 1, 0); PG8_SCHED; PG8_LDA(At, 1, 0); PG8_STAGE(PG8_SA(0, 1), a2 + hstep, voffA);
            PG8_WAIT_L(8); PG8_BAR; PG8_WAIT_L(0); PG8_MMA(0, 0, At, B0); PG8_BAR; PG8_SCHED;
            PG8_LDB(B1, 1, 1); PG8_STAGE(PG8_SB(1, 0), b3, voffB);
            PG8_BAR; PG8_WAIT_L(0); PG8_MMA(0, 1, At, B1); PG8_BAR;
            PG8_LDA(At, 1, 1); PG8_STAGE(PG8_SA(1, 0), a3, voffA);
            PG8_BAR; PG8_WAIT_L(0); PG8_MMA(1, 0, At, B0); PG8_BAR; PG8_SCHED;
            PG8_STAGE(PG8_SB(1, 1), b3 + hstep, voffB);
            PG8_WAIT_V(6); PG8_BAR; PG8_MMA(1, 1, At, B1); PG8_BAR;
            }
        }
        if constexpr (ALIGN_EPI) { if (wr == 0) PG8_BAR; }
        if constexpr (!Epi::AFTER_DRAIN) { E(acc, cur, wr, wc, fr, fq); S.done(cur); }
        if (!has_next) break;
#pragma unroll
        for (int a = 0; a < 2; ++a)
#pragma unroll
            for (int b = 0; b < 2; ++b)
#pragma unroll
                for (int m = 0; m < 4; ++m)
#pragma unroll
                    for (int n = 0; n < 2; ++n) acc[a][b][m][n] = (f32x4){0.f, 0.f, 0.f, 0.f};
        cur = nxt; cA = nA; cB = nB; ++ui;
        if constexpr (ALIGN_EPI) { if (wr == 1) PG8_BAR; }
    }
    PG8_WAIT_V(0);
    if constexpr (!ALIGN_EPI) { if (wr == 0) PG8_BAR; }
    PG8_BAR;
    if constexpr (Epi::AFTER_DRAIN) { E.fused(acc, cur, wr, wc, fr, fq, lds, wid, lane); S.done(cur); }
#undef PG8_SA
#undef PG8_SB
#undef PG8_STAGE
#undef PG8_LDA
#undef PG8_LDB
#undef PG8_MMA
#undef PG8_WAIT_V
#undef PG8_WAIT_L
#undef PG8_BAR
#undef PG8_SCHED
}
}
using pg8::bf16_t; using pg8::bf16x8; using pg8::f32x4; using pg8::u32x4;

constexpr int NTHR = 512, LDS_BYTES = 147456;
constexpr int D = 2048, SEQ = 4096, BATCH = 2, CTXL = 256, DFF = 5632, DIN = 5152, DINP = 5376;
constexpr int ML = BATCH * SEQ, MC = BATCH * CTXL, MT = ML + MC;
constexpr int NMOD = 9 * D;
constexpr float EPS = 1e-6f;
constexpr int PC_LX = 0, PC_LG = 1024, PC_Q = 2048, PC_K = 2560, PC_V = 3072, PC_O = 4096, PC_GT = 5120;
constexpr size_t MiB = 1u << 20;
constexpr size_t WS_MOD = 0, WS_WG = 1 * MiB, WS_WUP1 = 2 * MiB, WS_WDN1 = 46 * MiB, WS_WIN = 68 * MiB, WS_WOUT = 89 * MiB, WS_WUP2 = 97 * MiB, WS_WDN2 = 141 * MiB,
    WS_XN = 163 * MiB, WS_ACT = 197 * MiB  , WS_X = 291 * MiB, WS_G = 359 * MiB, WS_HL = 361 * MiB, WS_AC = 393 * MiB,
    WS_CSUM = 425 * MiB, WS_CARRY = 428 * MiB, WS_CST = 429 * MiB, WS_MSC = 464 * MiB, WS_YA = 465 * MiB, WS_CPREV = 497 * MiB, WS_END = 530 * MiB;
constexpr int CSTE = 8256;

struct Args { const float* in[25]; float* out; unsigned char* ws; };

__device__ __forceinline__ unsigned pk2(float lo, float hi) { return pg8::cvt_pk_bf16(lo, hi); }
__device__ __forceinline__ unsigned short f2bf(float f) { return (unsigned short)(pg8::cvt_pk_bf16(f, 0.f) & 0xffffu); }
__device__ __forceinline__ float bflo(unsigned w) { return __uint_as_float(w << 16); }
__device__ __forceinline__ float bfhi(unsigned w) { return __uint_as_float(w & 0xffff0000u); }
__device__ __forceinline__ float bf2f(unsigned short h) { return __uint_as_float((unsigned)h << 16); }
__device__ __forceinline__ float sigmoidf_(float x) { return 1.0f / (1.0f + __expf(-x)); }
__device__ __forceinline__ float siluf_(float x) { return x / (1.0f + __expf(-x)); }
__device__ __forceinline__ float logsigmoidf_(float x) { return fminf(x, 0.f) - log1pf(__expf(-fabsf(x))); }
__device__ __forceinline__ float gelu_tanhf_(float x) { const float u = 0.7978845608028654f * (x + 0.044715f * x * x * x); return 0.5f * x * (1.0f + tanhf(u)); }
__device__ __forceinline__ float wave_sum(float v) {
#pragma unroll
    for (int o = 1; o < 64; o <<= 1) v += __shfl_xor(v, o);
    return v;
}
__device__ __forceinline__ float wave_max(float v) {
#pragma unroll
    for (int o = 1; o < 64; o <<= 1) v = fmaxf(v, __shfl_xor(v, o));
    return v;
}
__device__ __forceinline__ float wave_incl_sum(float v, int lane) {
#pragma unroll
    for (int o = 1; o < 64; o <<= 1) { const float t = __shfl_up(v, o); if (lane >= o) v += t; }
    return v;
}
__device__ __forceinline__ float wave_incl_max(float v, int lane) {
#pragma unroll
    for (int o = 1; o < 64; o <<= 1) { const float t = __shfl_up(v, o); if (lane >= o) v = fmaxf(v, t); }
    return v;
}
__device__ __forceinline__ bf16x8 pack8(const float* p) {
    const f32x4 a = *(const f32x4*)p, b = *(const f32x4*)(p + 4);
    u32x4 w; w.x = pk2(a.x, a.y); w.y = pk2(a.z, a.w); w.z = pk2(b.x, b.y); w.w = pk2(b.z, b.w);
    return __builtin_bit_cast(bf16x8, w);
}
#define MFMA16(a, b, c) __builtin_amdgcn_mfma_f32_16x16x32_bf16((a), (b), (c), 0, 0, 0)

struct EpiSwiglu {
    static constexpr bool PERM = true, AFTER_DRAIN = false;
    bf16_t* O; int ldc;
    __device__ __forceinline__ void operator()(const f32x4 (&acc)[2][2][4][2], const pg8::Unit& u, int wr, int wc, int fr, int fq) const {
        const int row0 = u.pm * 256 + wr * 64 + fr, col0 = u.pn * 128 + wc * 32 + 8 * fq;
#pragma unroll
        for (int ai = 0; ai < 2; ++ai)
#pragma unroll
            for (int m = 0; m < 4; ++m) {
                bf16_t* rowp = O + (size_t)(row0 + ai * 128 + m * 16) * ldc + col0;
                const f32x4 g0 = acc[ai][0][m][0], g1 = acc[ai][0][m][1], u0 = acc[ai][1][m][0], u1 = acc[ai][1][m][1];
                u32x4 w;
                w.x = pk2(siluf_(g0[0]) * u0[0], siluf_(g0[1]) * u0[1]); w.y = pk2(siluf_(g0[2]) * u0[2], siluf_(g0[3]) * u0[3]);
                w.z = pk2(siluf_(g1[0]) * u1[0], siluf_(g1[1]) * u1[1]); w.w = pk2(siluf_(g1[2]) * u1[2], siluf_(g1[3]) * u1[3]);
                *(u32x4*)rowp = w;
            }
    }
};
struct EpiResid {
    static constexpr bool PERM = false, AFTER_DRAIN = false;
    const float* baseL; const float* baseC; float* out; const float* mod; int goff; float scale;
    __device__ __forceinline__ void operator()(const f32x4 (&acc)[2][2][4][2], const pg8::Unit& u, int wr, int wc, int fr, int fq) const {
        const int rowt = u.pm * 256; const int mr = rowt < ML ? (rowt >> 12) : 2;
        const float* bp = rowt < ML ? baseL : baseC - (size_t)ML * D;
        const float* gp = mod + (size_t)mr * NMOD + goff;
        const int col0 = u.pn * 256 + wc * 32 + 4 * fq;
#pragma unroll
        for (int bj = 0; bj < 2; ++bj)
#pragma unroll
            for (int n = 0; n < 2; ++n) {
                const int c = col0 + bj * 128 + n * 16;
                const f32x4 gv = *(const f32x4*)(gp + c) * scale;
#pragma unroll
                for (int ai = 0; ai < 2; ++ai)
#pragma unroll
                    for (int m = 0; m < 4; ++m) {
                        const size_t off = (size_t)(rowt + ai * 128 + wr * 64 + m * 16 + fr) * D + c;
                        const f32x4 bs = *(const f32x4*)(bp + off);
                        *(f32x4*)(out + off) = bs + gv * acc[ai][bj][m][n];
                    }
                asm volatile("" ::: "memory");
            }
    }
};
struct EpiInProj {
    static constexpr bool PERM = true, AFTER_DRAIN = false;
    bf16_t* P; float* G; const float* bm;
    __device__ __forceinline__ void operator()(const f32x4 (&acc)[2][2][4][2], const pg8::Unit& u, int wr, int wc, int fr, int fq) const {
        const int row0 = u.pm * 256 + wr * 64 + fr, col0 = u.pn * 256 + wc * 32 + 8 * fq;
        const bool gates = (u.pn == PC_GT / 256) && (wc == 0);
#pragma unroll
        for (int ai = 0; ai < 2; ++ai)
#pragma unroll
            for (int m = 0; m < 4; ++m) {
                const int row = row0 + ai * 128 + m * 16;
                bf16_t* rowp = P + (size_t)row * DINP + col0;
#pragma unroll
                for (int bj = 0; bj < 2; ++bj) {
                    const f32x4 v0 = acc[ai][bj][m][0], v1 = acc[ai][bj][m][1];
                    u32x4 w; w.x = pk2(v0[0], v0[1]); w.y = pk2(v0[2], v0[3]); w.z = pk2(v1[0], v1[1]); w.w = pk2(v1[2], v1[3]);
                    *(u32x4*)(rowp + bj * 128) = w;
                }
                if (gates) {
                    const f32x4 b0 = *(const f32x4*)(bm + 8 * fq), b1 = *(const f32x4*)(bm + 8 * fq + 4);
                    *(f32x4*)(G + (size_t)row * 32 + 8 * fq) = acc[ai][0][m][0] + b0;
                    *(f32x4*)(G + (size_t)row * 32 + 8 * fq + 4) = acc[ai][0][m][1] + b1;
                }
            }
    }
};

__device__ __forceinline__ void transpose_item(const float* __restrict__ W, int K, int N, bf16_t* __restrict__ WT, int k0, int n0, int drow0, float* scr, int lane) {
#pragma unroll 8
    for (int i = 0; i < 32; ++i) { const int kk = 2 * i + (lane >> 5); scr[kk * 33 + (lane & 31)] = W[(size_t)(k0 + kk) * N + n0 + (lane & 31)]; }
    __builtin_amdgcn_s_waitcnt(0); asm volatile("" ::: "memory");
    const int c = lane & 7;
#pragma unroll
    for (int j = 0; j < 4; ++j) { const int n = (lane >> 3) + 8 * j; const float* s = scr + (8 * c) * 33 + n;
        u32x4 o; o.x = pk2(s[0 * 33], s[1 * 33]); o.y = pk2(s[2 * 33], s[3 * 33]); o.z = pk2(s[4 * 33], s[5 * 33]); o.w = pk2(s[6 * 33], s[7 * 33]);
        *(u32x4*)(WT + (size_t)(drow0 + n) * K + k0 + 8 * c) = o; }
    __builtin_amdgcn_s_waitcnt(0); asm volatile("" ::: "memory");
}
__device__ __forceinline__ int swiglu_row(int n0) {
    return n0 < DFF ? 256 * (n0 >> 7) + (n0 & 127) : 256 * ((n0 - DFF) >> 7) + 128 + ((n0 - DFF) & 127);
}
constexpr int T_UP = 32 * 352, T_DN = 88 * 64, T_IN = 32 * 161, T_OUT = 32 * 64, T_G = 256;
constexpr int T_ALL = 2 * T_UP + 2 * T_DN + T_IN + T_OUT + T_G;
__device__ __forceinline__ void p0_item(const Args& a, int it, float* scr, int lane) {
    unsigned char* ws = a.ws;
    if (it < 2 * T_UP) { const int w = it >= T_UP; const int r = it - w * T_UP; const int kb = r / 352, nb = r % 352;
        transpose_item(a.in[w ? 22 : 7], D, 2 * DFF, (bf16_t*)(ws + (w ? WS_WUP2 : WS_WUP1)), 64 * kb, 32 * nb, swiglu_row(32 * nb), scr, lane); return; }
    it -= 2 * T_UP;
    if (it < 2 * T_DN) { const int w = it >= T_DN; const int r = it - w * T_DN; const int kb = r / 64, nb = r % 64;
        transpose_item(a.in[w ? 23 : 8], DFF, D, (bf16_t*)(ws + (w ? WS_WDN2 : WS_WDN1)), 64 * kb, 32 * nb, 32 * nb, scr, lane); return; }
    it -= 2 * T_DN;
    if (it < T_IN) { const int kb = it / 161, nb = it % 161; transpose_item(a.in[10], D, DIN, (bf16_t*)(ws + WS_WIN), 64 * kb, 32 * nb, 32 * nb, scr, lane); return; }
    it -= T_IN;
    if (it < T_OUT) { const int kb = it / 64, nb = it % 64; transpose_item(a.in[20], D, D, (bf16_t*)(ws + WS_WOUT), 64 * kb, 32 * nb, 32 * nb, scr, lane); return; }
    it -= T_OUT;
    { const int mi = it >> 3, sub = it & 7, g = mi >> 4, d = (mi >> 3) & 1, n = mi & 7;
      transpose_item(a.in[g ? 16 : 14] + (size_t)(d * 8 + n) * 16384, 128, 128, (bf16_t*)(ws + WS_WG) + (size_t)((n * 2 + d) * 2 + g) * 16384, 64 * (sub >> 2), 32 * (sub & 3), 32 * (sub & 3), scr, lane); }
}
__device__ __forceinline__ void phase0(const Args& a, unsigned char* lds, int tid, int lane, int wave) {
    const int G = gridDim.x, bx = blockIdx.x;
    float* sc = (float*)lds;
    float* red = (float*)(lds + 24576);
    float* mod = (float*)(a.ws + WS_MOD);
    if (bx < 144) {
        for (int i = tid; i < 3 * D; i += NTHR) { const int r = i >> 11, k = i & 2047; const float c = r < 2 ? a.in[1][r * D + k] : a.in[3][k]; sc[i] = siluf_(c); }
        __syncthreads();
        for (int it = bx; it < 144; it += G) {
            const float* w = a.in[4] + (size_t)(wave * 256) * NMOD + it * 128 + 2 * lane;
            float a00 = 0.f, a01 = 0.f, a10 = 0.f, a11 = 0.f, a20 = 0.f, a21 = 0.f;
#pragma unroll 8
            for (int k = 0; k < 256; ++k) {
                const float2 wv = *(const float2*)(w + (size_t)k * NMOD);
                const float s0 = sc[wave * 256 + k], s1 = sc[D + wave * 256 + k], s2 = sc[2 * D + wave * 256 + k];
                a00 += s0 * wv.x; a01 += s0 * wv.y; a10 += s1 * wv.x; a11 += s1 * wv.y; a20 += s2 * wv.x; a21 += s2 * wv.y;
            }
            red[(wave * 6 + 0) * 64 + lane] = a00; red[(wave * 6 + 1) * 64 + lane] = a01; red[(wave * 6 + 2) * 64 + lane] = a10;
            red[(wave * 6 + 3) * 64 + lane] = a11; red[(wave * 6 + 4) * 64 + lane] = a20; red[(wave * 6 + 5) * 64 + lane] = a21;
            __syncthreads();
            if (tid < 384) { const int r = tid >> 7, cc = tid & 127; float s = a.in[5][it * 128 + cc];
#pragma unroll
                for (int w8 = 0; w8 < 8; ++w8) s += red[(w8 * 6 + r * 2 + (cc & 1)) * 64 + (cc >> 1)];
                mod[(size_t)r * NMOD + it * 128 + cc] = s; }
            __syncthreads();
        }
    }
    __syncthreads();
    { u32x4* z = (u32x4*)((bf16_t*)(a.ws + WS_WIN) + (size_t)DIN * D); const int nz = (DINP - DIN) * D / 8;
      for (int i = bx * NTHR + tid; i < nz; i += G * NTHR) z[i] = (u32x4){0u, 0u, 0u, 0u}; }
    float* scr = (float*)(lds + wave * 16384);
    if (G == 256) {
        const int start = bx < 144 ? 106 * bx : 144 * 106 + 232 * (bx - 144), cnt = bx < 144 ? 106 : 232;
        for (int i = wave; i < cnt; i += 8) p0_item(a, start + i, scr, lane);
    } else {
        for (int it = bx * 8 + wave; it < T_ALL; it += G * 8) p0_item(a, it, scr, lane);
    }
}
static_assert(144 * 106 + 112 * 232 == T_ALL, "phase-0 split");

__device__ __forceinline__ void norm_mod_rows(const float* srcL, const float* srcC, int nrows, const float* gnorm, const float* mod, int sub, bf16_t* XN, int gw, int NGW, int lane) {
    for (int m = gw; m < nrows; m += NGW) {
        const float* xr = m < ML ? srcL + (size_t)m * D : srcC + (size_t)(m - ML) * D;
        const int mr = m < ML ? (m >> 12) : 2;
        const float* sh = mod + (size_t)mr * NMOD + (3 * sub) * D; const float* scl = sh + D;
        f32x4 v[8]; float s = 0.f;
#pragma unroll
        for (int j = 0; j < 8; ++j) { v[j] = ((const f32x4*)xr)[lane + 64 * j]; s += (v[j].x * v[j].x + v[j].y * v[j].y) + (v[j].z * v[j].z + v[j].w * v[j].w); }
        const float r = 1.0f / sqrtf(wave_sum(s) * (1.0f / D) + EPS);
        unsigned long long* o8 = (unsigned long long*)(XN + (size_t)m * D) + lane;
#pragma unroll
        for (int j = 0; j < 8; ++j) {
            const f32x4 g = ((const f32x4*)gnorm)[lane + 64 * j], shv = ((const f32x4*)sh)[lane + 64 * j], scv = ((const f32x4*)scl)[lane + 64 * j];
            const f32x4 y = (v[j] * r * g) * (scv + 1.0f) + shv;
            o8[64 * j] = (unsigned long long)pk2(y.x, y.y) | ((unsigned long long)pk2(y.z, y.w) << 32);
        }
    }
}
__device__ __forceinline__ void final_norm_rows(const float* X, const float* gnorm, float* out, int gw, int NGW, int lane) {
    for (int m = gw; m < ML; m += NGW) {
        const f32x4* xr = (const f32x4*)(X + (size_t)m * D) + lane;
        f32x4 v[8]; float s = 0.f;
#pragma unroll
        for (int j = 0; j < 8; ++j) { v[j] = xr[64 * j]; s += (v[j].x * v[j].x + v[j].y * v[j].y) + (v[j].z * v[j].z + v[j].w * v[j].w); }
        const float r = 1.0f / sqrtf(wave_sum(s) * (1.0f / D) + EPS);
        f32x4* o = (f32x4*)(out + (size_t)m * D) + lane;
#pragma unroll
        for (int j = 0; j < 8; ++j) { const f32x4 g = ((const f32x4*)gnorm)[lane + 64 * j]; o[64 * j] = v[j] * r * g; }
    }
}

__device__ __forceinline__ void lru_local_item(unsigned char* lds, int item, const Args& a, int tid, int lane, int wave) {
    const bf16_t* P = (const bf16_t*)(a.ws + WS_ACT);
    const bf16_t* WG = (const bf16_t*)(a.ws + WS_WG);
    bf16_t* HL = (bf16_t*)(a.ws + WS_HL); bf16_t* AC = (bf16_t*)(a.ws + WS_AC);
    float* CSUM = (float*)(a.ws + WS_CSUM);
    float* XC = (float*)lds;
    float* LA = (float*)(lds + 33792);
    float* LB = (float*)(lds + 67584);
    float* SEG = (float*)(lds + 101376);
    const int n = item & 7, sc = item >> 3;
    int b, ck, rowbase, seqlen, chunkidx; bool islat;
    if (sc < 128) { b = sc >> 6; ck = sc & 63; rowbase = b * SEQ; seqlen = SEQ; islat = true; chunkidx = 4 + ck; }
    else { const int s2 = sc - 128; b = s2 >> 2; ck = s2 & 3; rowbase = ML + b * CTXL; seqlen = CTXL; islat = false; chunkidx = ck; }
    const int t0 = ck * 64;
    {
        const int tok = tid >> 3, c8 = tid & 7, ch0 = n * 128 + c8 * 16;
        float accv[16];
#pragma unroll
        for (int i = 0; i < 16; i += 4) { const f32x4 bb = *(const f32x4*)(a.in[13] + ch0 + i); accv[i] = bb.x; accv[i + 1] = bb.y; accv[i + 2] = bb.z; accv[i + 3] = bb.w; }
#pragma unroll
        for (int k = 0; k < 4; ++k) {
            const int t = t0 + tok + k - 2;
            if (t >= 0 && t < seqlen) {
                const u32x4* src = (const u32x4*)(P + (size_t)(rowbase + t) * DINP + PC_LX + ch0);
                const u32x4 x0 = src[0], x1 = src[1];
                const float* cw = a.in[12] + k * 1024 + ch0;
                const unsigned xw[8] = {x0.x, x0.y, x0.z, x0.w, x1.x, x1.y, x1.z, x1.w};
#pragma unroll
                for (int i = 0; i < 8; ++i) { accv[2 * i] += cw[2 * i] * bflo(xw[i]); accv[2 * i + 1] += cw[2 * i + 1] * bfhi(xw[i]); }
            }
        }
#pragma unroll
        for (int i = 0; i < 16; i += 4) *(f32x4*)(XC + tok * 132 + c8 * 16 + i) = (f32x4){accv[i], accv[i + 1], accv[i + 2], accv[i + 3]};
    }
    __syncthreads();
    const int fr = lane & 15, fq = lane >> 4;
#pragma unroll 1
    for (int d = 0; d < 2; ++d) {
        {
            const int col = 16 * wave + fr, ch = n * 128 + col;
            const bf16_t* wg = WG + (size_t)((n * 2 + d) * 2) * 16384 + (size_t)col * 128 + fq * 8;
            bf16x8 Br[4], Bi[4];
#pragma unroll
            for (int ks = 0; ks < 4; ++ks) { Br[ks] = *(const bf16x8*)(wg + ks * 32); Bi[ks] = *(const bf16x8*)(wg + 16384 + ks * 32); }
            const float brv = a.in[15][d * 1024 + ch], biv = a.in[17][d * 1024 + ch];
            const float sp = log1pf(__expf(-a.in[18][d * 1024 + ch]));
#pragma unroll
            for (int m = 0; m < 4; ++m) {
                f32x4 ar = {0.f, 0.f, 0.f, 0.f}, ai = {0.f, 0.f, 0.f, 0.f};
#pragma unroll
                for (int ks = 0; ks < 4; ++ks) { const bf16x8 A = pack8(XC + (16 * m + fr) * 132 + ks * 32 + fq * 8); ar = MFMA16(A, Br[ks], ar); ai = MFMA16(A, Bi[ks], ai); }
#pragma unroll
                for (int j = 0; j < 4; ++j) {
                    const int tok = 16 * m + 4 * fq + j;
                    const float r = sigmoidf_(ar[j] + brv), ii = sigmoidf_(ai[j] + biv);
                    const float la = -8.0f * r * sp, av = __expf(la), mult = sqrtf(fmaxf(-expm1f(2.0f * la), 0.f));
                    LA[tok * 132 + col] = av; LB[tok * 132 + col] = mult * ii * XC[tok * 132 + col];
                }
            }
        }
        __syncthreads();
        {
            const int seg = tid >> 7, ch = tid & 127;
            float hl[16], Al[16]; float h = 0.f, A = 1.f;
#pragma unroll
            for (int qi = 0; qi < 16; ++qi) { const int q = seg * 16 + qi, tok = d ? 63 - q : q; const float av = LA[tok * 132 + ch], bx = LB[tok * 132 + ch]; h = av * h + bx; A *= av; hl[qi] = h; Al[qi] = A; }
            SEG[(seg * 128 + ch) * 2] = A; SEG[(seg * 128 + ch) * 2 + 1] = h;
            __syncthreads();
            float carry = 0.f, Ap = 1.f;
#pragma unroll
            for (int s = 0; s < 3; ++s) if (s < seg) { const float As = SEG[(s * 128 + ch) * 2], hs = SEG[(s * 128 + ch) * 2 + 1]; carry = As * carry + hs; Ap *= As; }
            float Hlast = 0.f, Alast = 0.f;
#pragma unroll
            for (int qi = 0; qi < 16; ++qi) {
                const int q = seg * 16 + qi, tok = d ? 63 - q : q;
                const float H = hl[qi] + Al[qi] * carry, Ac = Al[qi] * Ap; Hlast = H; Alast = Ac;
                if (islat) { const size_t o = ((size_t)d * ML + rowbase + t0 + tok) * 1024 + n * 128 + ch; HL[o] = f2bf(H); AC[o] = f2bf(Ac); }
            }
            if (seg == 3) { const size_t o = ((size_t)((d * 2 + b) * 68 + chunkidx) * 2) * 1024 + n * 128 + ch; CSUM[o] = Alast; CSUM[o + 1024] = Hlast; }
        }
        __syncthreads();
    }
}

__device__ __forceinline__ void lru_carry(const Args& a, int gtid, int nthr) {
    const float* __restrict__ CSUM = (const float*)(a.ws + WS_CSUM);
    float* __restrict__ CARRY = (float*)(a.ws + WS_CARRY);
    for (int idx = gtid; idx < 4096; idx += nthr) {
        const int ch = idx & 1023, b = (idx >> 10) & 1, d = idx >> 11;
        const float* base = CSUM + (size_t)((d * 2 + b) * 68) * 2 * 1024 + ch;
        float carry = 0.f;
#pragma unroll 1
        for (int half = 0; half < 2; ++half) {
            float Av[34], hv[34];
#pragma unroll
            for (int s = 0; s < 34; ++s) { const int st = half * 34 + s; const int chunk = d == 0 ? st : (st < 4 ? 3 - st : 71 - st);
                Av[s] = base[(size_t)(chunk * 2) * 1024]; hv[s] = base[(size_t)(chunk * 2 + 1) * 1024]; }
#pragma unroll
            for (int s = 0; s < 34; ++s) { const int st = half * 34 + s; const int chunk = d == 0 ? st : (st < 4 ? 3 - st : 71 - st);
                if (chunk >= 4) CARRY[(size_t)((d * 2 + b) * 64 + (chunk - 4)) * 1024 + ch] = carry;
                carry = Av[s] * carry + hv[s]; }
        }
    }
}

__device__ __forceinline__ void lru_combine_rows(const Args& a, int gw, int NGW, int lane) {
    const bf16_t* P = (const bf16_t*)(a.ws + WS_ACT);
    const bf16_t* HL = (const bf16_t*)(a.ws + WS_HL); const bf16_t* AC = (const bf16_t*)(a.ws + WS_AC);
    const float* CARRY = (const float*)(a.ws + WS_CARRY);
    bf16_t* YA = (bf16_t*)(a.ws + WS_YA);
    for (int r = gw; r < ML; r += NGW) {
        const int b = r >> 12, ck = (r & 4095) >> 6;
#pragma unroll
        for (int jj = 0; jj < 2; ++jj) {
            const int ch = 8 * lane + 512 * jj;
            const u32x4 hf = *(const u32x4*)(HL + (size_t)r * 1024 + ch), af = *(const u32x4*)(AC + (size_t)r * 1024 + ch);
            const u32x4 hb = *(const u32x4*)(HL + ((size_t)ML + r) * 1024 + ch), ab = *(const u32x4*)(AC + ((size_t)ML + r) * 1024 + ch);
            const u32x4 lg = *(const u32x4*)(P + (size_t)r * DINP + PC_LG + ch);
            const float* cfp = CARRY + (size_t)((0 * 2 + b) * 64 + ck) * 1024 + ch; const float* cbp = CARRY + (size_t)((1 * 2 + b) * 64 + ck) * 1024 + ch;
            const f32x4 cf0 = *(const f32x4*)cfp, cf1 = *(const f32x4*)(cfp + 4), cb0 = *(const f32x4*)cbp, cb1 = *(const f32x4*)(cbp + 4);
            const float cf[8] = {cf0.x, cf0.y, cf0.z, cf0.w, cf1.x, cf1.y, cf1.z, cf1.w}, cb[8] = {cb0.x, cb0.y, cb0.z, cb0.w, cb1.x, cb1.y, cb1.z, cb1.w};
            const unsigned hfw[4] = {hf.x, hf.y, hf.z, hf.w}, afw[4] = {af.x, af.y, af.z, af.w}, hbw[4] = {hb.x, hb.y, hb.z, hb.w}, abw[4] = {ab.x, ab.y, ab.z, ab.w}, lgw[4] = {lg.x, lg.y, lg.z, lg.w};
            unsigned ow[4];
#pragma unroll
            for (int i = 0; i < 4; ++i) {
                const float r0 = bflo(hfw[i]) + bflo(afw[i]) * cf[2 * i] + bflo(hbw[i]) + bflo(abw[i]) * cb[2 * i];
                const float r1 = bfhi(hfw[i]) + bfhi(afw[i]) * cf[2 * i + 1] + bfhi(hbw[i]) + bfhi(abw[i]) * cb[2 * i + 1];
                ow[i] = pk2(gelu_tanhf_(bflo(lgw[i])) * r0, gelu_tanhf_(bfhi(lgw[i])) * r1);
            }
            *(u32x4*)(YA + (size_t)r * D + ch) = (u32x4){ow[0], ow[1], ow[2], ow[3]};
        }
    }
}

__device__ __forceinline__ int mrow_lat(int b, int p) { return b * SEQ + ((p & 63) << 6) + (p >> 6); }

__device__ __forceinline__ void mlstm_local_item(unsigned char* lds, int item, const Args& a, int tid, int lane, int wave) {
    const bf16_t* P = (const bf16_t*)(a.ws + WS_ACT);
    const float* Gt = (const float*)(a.ws + WS_G);
    float* CST = (float*)(a.ws + WS_CST); float* MSC = (float*)(a.ws + WS_MSC);
    bf16_t* VT = (bf16_t*)lds;
    bf16_t* KW = (bf16_t*)(lds + 34816);
    float* WGs = (float*)(lds + 69632);
    const int cidx = item % 34, bh = item / 34, h = bh & 7, b = bh >> 3;
    const int chain0 = (b * 8 + h) * 2;
#define MROW(j) (cidx < 2 ? ML + b * CTXL + cidx * 128 + (j) : mrow_lat(b, (cidx - 2) * 128 + (j)))
    if (wave < 2) {
        const int d = wave;
        const int j0 = d ? 127 - 2 * lane : 2 * lane, j1 = d ? 126 - 2 * lane : 2 * lane + 1;
        const float* g0p = Gt + (size_t)MROW(j0) * 32 + h; const float* g1p = Gt + (size_t)MROW(j1) * 32 + h;
        const float ig0 = g0p[(2 * d) * 8], fg0 = g0p[(2 * d + 1) * 8], ig1 = g1p[(2 * d) * 8], fg1 = g1p[(2 * d + 1) * 8];
        const float l0 = logsigmoidf_(fg0), l1 = logsigmoidf_(fg1);
        const float s1 = l0 + l1, incl = wave_incl_sum(s1, lane), excl = incl - s1, bc0 = excl + l0, bc1 = excl + s1;
        const float blast = __shfl(incl, 63);
        const float gg0 = blast - bc0 + ig0, gg1 = blast - bc1 + ig1;
        const float mloc = wave_max(fmaxf(gg0, gg1));
        WGs[d * 128 + j0] = __expf(gg0 - mloc); WGs[d * 128 + j1] = __expf(gg1 - mloc);
        if (lane == 0) { MSC[(size_t)((chain0 + d) * 34 + cidx) * 2] = mloc; MSC[(size_t)((chain0 + d) * 34 + cidx) * 2 + 1] = blast; }
    }
    const int j = tid >> 2, q4 = tid & 3; const size_t prow = (size_t)MROW(j) * DINP;
    {
        const u32x4* vs = (const u32x4*)(P + prow + PC_V + h * 128 + q4 * 32);
#pragma unroll
        for (int c = 0; c < 4; ++c) { const u32x4 x = vs[c]; const unsigned xw[4] = {x.x, x.y, x.z, x.w};
#pragma unroll
            for (int i = 0; i < 4; ++i) { VT[(q4 * 32 + c * 8 + 2 * i) * 136 + j] = (bf16_t)(xw[i] & 0xffffu); VT[(q4 * 32 + c * 8 + 2 * i + 1) * 136 + j] = (bf16_t)(xw[i] >> 16); } }
    }
    const u32x4* ks_ = (const u32x4*)(P + prow + PC_K + h * 64 + q4 * 16);
    const u32x4 k0 = ks_[0], k1 = ks_[1];
    __syncthreads();
    {
        const unsigned kw[8] = {k0.x, k0.y, k0.z, k0.w, k1.x, k1.y, k1.z, k1.w};
#pragma unroll
        for (int d = 0; d < 2; ++d) { const float w = WGs[d * 128 + j] * 0.125f;
#pragma unroll
            for (int i = 0; i < 8; ++i) { KW[(d * 64 + q4 * 16 + 2 * i) * 136 + j] = f2bf(bflo(kw[i]) * w); KW[(d * 64 + q4 * 16 + 2 * i + 1) * 136 + j] = f2bf(bfhi(kw[i]) * w); } }
    }
    __syncthreads();
    const int fr = lane & 15, fq = lane >> 4;
#pragma unroll
    for (int d = 0; d < 2; ++d) {
        f32x4 acc[4];
#pragma unroll
        for (int nt = 0; nt < 4; ++nt) acc[nt] = (f32x4){0.f, 0.f, 0.f, 0.f};
#pragma unroll
        for (int ks = 0; ks < 4; ++ks) {
            const bf16x8 A = *(const bf16x8*)(VT + (16 * wave + fr) * 136 + ks * 32 + fq * 8);
#pragma unroll
            for (int nt = 0; nt < 4; ++nt) { const bf16x8 B = *(const bf16x8*)(KW + (d * 64 + 16 * nt + fr) * 136 + ks * 32 + fq * 8); acc[nt] = MFMA16(A, B, acc[nt]); }
        }
        float* dst = CST + (size_t)((chain0 + d) * 34 + cidx) * CSTE;
#pragma unroll
        for (int nt = 0; nt < 4; ++nt)
#pragma unroll
            for (int i = 0; i < 4; ++i) dst[(16 * wave + 4 * fq + i) * 64 + 16 * nt + fr] = acc[nt][i];
    }
    if (tid < 128) { const int d = tid >> 6, k = tid & 63; float s = 0.f;
        for (int jj = 0; jj < 128; jj += 2) { const unsigned w = *(const unsigned*)(KW + (d * 64 + k) * 136 + jj); s += bflo(w) + bfhi(w); }
        CST[(size_t)((chain0 + d) * 34 + cidx) * CSTE + 8192 + k] = s; }
    __syncthreads();
#undef MROW
}

__device__ __forceinline__ void mlstm_state_scan(const Args& a, int gtid, int nthr) {
    const float* __restrict__ CST = (const float*)(a.ws + WS_CST);
    const float* __restrict__ MSC = (const float*)(a.ws + WS_MSC);
    float* __restrict__ CPREV = (float*)(a.ws + WS_CPREV);
    float* __restrict__ MPREV = (float*)(a.ws + WS_MSC + 65536);
    for (int idx = gtid; idx < 32 * CSTE; idx += nthr) {
        const int chain = idx / CSTE, e = idx - chain * CSTE, d = chain & 1;
        float tv[34];
#pragma unroll
        for (int s = 0; s < 34; ++s) { const int cidx = d == 0 ? s : (s < 2 ? 1 - s : 35 - s); tv[s] = CST[(size_t)(chain * 34 + cidx) * CSTE + e]; }
        float val = 0.f, m = 0.f;
#pragma unroll
        for (int s = 0; s < 34; ++s) {
            const int cidx = d == 0 ? s : (s < 2 ? 1 - s : 35 - s);
            const float mloc = MSC[(size_t)(chain * 34 + cidx) * 2], bl = MSC[(size_t)(chain * 34 + cidx) * 2 + 1];
            if (cidx >= 2) { CPREV[(size_t)(chain * 32 + cidx - 2) * CSTE + e] = val; if (e == 0) MPREV[chain * 32 + cidx - 2] = m; }
            const float mn = fmaxf(bl + m, mloc);
            val = __expf(bl + m - mn) * val + __expf(mloc - mn) * tv[s]; m = mn;
        }
    }
}

__device__ __forceinline__ void mlstm_out_item(unsigned char* lds, int item, const Args& a, int tid, int lane, int wave) {
    const bf16_t* P = (const bf16_t*)(a.ws + WS_ACT);
    const float* Gt = (const float*)(a.ws + WS_G);
    const float* CPREV = (const float*)(a.ws + WS_CPREV); const float* MPREV = (const float*)(a.ws + WS_MSC + 65536);
    bf16_t* YA = (bf16_t*)(a.ws + WS_YA);
    bf16_t* Qs = (bf16_t*)lds;
    bf16_t* Ks = (bf16_t*)(lds + 18432);
    bf16_t* VT = (bf16_t*)(lds + 36864);
    bf16_t* Ws = (bf16_t*)(lds + 71680);
    bf16_t* Cs = (bf16_t*)(lds + 106496);
    float* BC = (float*)(lds + 127232);
    float* UU = (float*)(lds + 127232 + 1024);
    float* MM = (float*)(lds + 127232 + 2048);
    float* MP = (float*)(lds + 127232 + 3072);
    const int c = item & 31, bh = item >> 5, h = bh & 7, b = bh >> 3;
    const int chain0 = (b * 8 + h) * 2;
    if (wave < 2) {
        const int d = wave; const float mprev = MPREV[(chain0 + d) * 32 + c];
        const int j0 = d ? 127 - 2 * lane : 2 * lane, j1 = d ? 126 - 2 * lane : 2 * lane + 1;
        const float* g0p = Gt + (size_t)mrow_lat(b, c * 128 + j0) * 32 + h; const float* g1p = Gt + (size_t)mrow_lat(b, c * 128 + j1) * 32 + h;
        const float ig0 = g0p[(2 * d) * 8], fg0 = g0p[(2 * d + 1) * 8], ig1 = g1p[(2 * d) * 8], fg1 = g1p[(2 * d + 1) * 8];
        const float l0 = logsigmoidf_(fg0), l1 = logsigmoidf_(fg1);
        const float s1 = l0 + l1, incl = wave_incl_sum(s1, lane), excl = incl - s1, bc0 = excl + l0, bc1 = excl + s1;
        const float u0 = ig0 - bc0, u1 = ig1 - bc1;
        const float p1 = fmaxf(u0, u1), inclm = wave_incl_max(p1, lane);
        float exclm = __shfl_up(inclm, 1); if (lane == 0) exclm = -INFINITY;
        BC[d * 128 + j0] = bc0; BC[d * 128 + j1] = bc1; UU[d * 128 + j0] = u0; UU[d * 128 + j1] = u1;
        MM[d * 128 + j0] = fmaxf(mprev, fmaxf(exclm, u0)); MM[d * 128 + j1] = fmaxf(mprev, fmaxf(exclm, p1));
        if (lane == 0) MP[d] = mprev;
    }
    {
        const int j = tid >> 2, q4 = tid & 3; const size_t prow = (size_t)mrow_lat(b, c * 128 + j) * DINP;
        const u32x4* qs_ = (const u32x4*)(P + prow + PC_Q + h * 64 + q4 * 16);
        *(u32x4*)(Qs + j * 72 + q4 * 16) = qs_[0]; *(u32x4*)(Qs + j * 72 + q4 * 16 + 8) = qs_[1];
        const u32x4* ks_ = (const u32x4*)(P + prow + PC_K + h * 64 + q4 * 16);
#pragma unroll
        for (int cc = 0; cc < 2; ++cc) { const u32x4 x = ks_[cc]; u32x4 y;
            y.x = pk2(bflo(x.x) * 0.125f, bfhi(x.x) * 0.125f); y.y = pk2(bflo(x.y) * 0.125f, bfhi(x.y) * 0.125f); y.z = pk2(bflo(x.z) * 0.125f, bfhi(x.z) * 0.125f); y.w = pk2(bflo(x.w) * 0.125f, bfhi(x.w) * 0.125f);
            *(u32x4*)(Ks + j * 72 + q4 * 16 + cc * 8) = y; }
        const u32x4* vs = (const u32x4*)(P + prow + PC_V + h * 128 + q4 * 32);
#pragma unroll
        for (int cc = 0; cc < 4; ++cc) { const u32x4 x = vs[cc]; const unsigned xw[4] = {x.x, x.y, x.z, x.w};
#pragma unroll
            for (int i = 0; i < 4; ++i) { VT[(q4 * 32 + cc * 8 + 2 * i) * 136 + j] = (bf16_t)(xw[i] & 0xffffu); VT[(q4 * 32 + cc * 8 + 2 * i + 1) * 136 + j] = (bf16_t)(xw[i] >> 16); } }
    }
    for (int i = tid; i < 540; i += NTHR) ((unsigned*)(Cs + 129 * 72))[i] = 0u;
    __syncthreads();
    const int fr = lane & 15, fq = lane >> 4, trow = 16 * wave + 4 * fq;
    f32x4 S[8];
#pragma unroll
    for (int nt = 0; nt < 8; ++nt) S[nt] = (f32x4){0.f, 0.f, 0.f, 0.f};
#pragma unroll
    for (int ks = 0; ks < 2; ++ks) {
        const bf16x8 A = *(const bf16x8*)(Qs + (16 * wave + fr) * 72 + ks * 32 + fq * 8);
#pragma unroll
        for (int nt = 0; nt < 8; ++nt) { const bf16x8 B = *(const bf16x8*)(Ks + (16 * nt + fr) * 72 + ks * 32 + fq * 8); S[nt] = MFMA16(A, B, S[nt]); }
    }
    f32x4 hsum[8];
#pragma unroll
    for (int nt = 0; nt < 8; ++nt) hsum[nt] = (f32x4){0.f, 0.f, 0.f, 0.f};
#pragma unroll 1
    for (int d = 0; d < 2; ++d) {
        { const f32x4* src = (const f32x4*)(CPREV + (size_t)((chain0 + d) * 32 + c) * CSTE);
          for (int i = tid; i < CSTE / 4; i += NTHR) { const f32x4 x = src[i]; const int e = i * 4, v = e >> 6, k = e & 63;
              *(unsigned long long*)(Cs + v * 72 + k) = (unsigned long long)pk2(x.x, x.y) | ((unsigned long long)pk2(x.z, x.w) << 32); } }
        float Mt[4], den2[4];
#pragma unroll
        for (int i = 0; i < 4; ++i) { Mt[i] = MM[d * 128 + trow + i]; den2[i] = 0.f; }
#pragma unroll
        for (int nt = 0; nt < 8; ++nt) {
            const int s = 16 * nt + fr; const float us = UU[d * 128 + s];
#pragma unroll
            for (int i = 0; i < 4; ++i) { const int t = trow + i; const bool ok = d ? (s >= t) : (s <= t);
                const float wv = ok ? S[nt][i] * __expf(us - Mt[i]) : 0.f; den2[i] += wv; Ws[t * 136 + s] = f2bf(wv); }
        }
#pragma unroll
        for (int i = 0; i < 4; ++i) { float v = den2[i]; v += __shfl_xor(v, 1); v += __shfl_xor(v, 2); v += __shfl_xor(v, 4); v += __shfl_xor(v, 8); den2[i] = v; }
        __syncthreads();
        f32x4 O[9];
#pragma unroll
        for (int nt = 0; nt < 9; ++nt) O[nt] = (f32x4){0.f, 0.f, 0.f, 0.f};
#pragma unroll
        for (int ks = 0; ks < 2; ++ks) {
            const bf16x8 A = *(const bf16x8*)(Qs + (16 * wave + fr) * 72 + ks * 32 + fq * 8);
#pragma unroll
            for (int nt = 0; nt < 9; ++nt) { const bf16x8 B = *(const bf16x8*)(Cs + (16 * nt + fr) * 72 + ks * 32 + fq * 8); O[nt] = MFMA16(A, B, O[nt]); }
        }
        const float mprev = MP[d];
        float si[4], den1[4];
#pragma unroll
        for (int i = 0; i < 4; ++i) { si[i] = __expf(mprev - Mt[i]); den1[i] = __shfl(O[8][i], lane & 48); }
#pragma unroll
        for (int nt = 0; nt < 8; ++nt)
#pragma unroll
            for (int i = 0; i < 4; ++i) O[nt][i] *= si[i];
#pragma unroll
        for (int ks = 0; ks < 4; ++ks) {
            const bf16x8 A = *(const bf16x8*)(Ws + (16 * wave + fr) * 136 + ks * 32 + fq * 8);
#pragma unroll
            for (int nt = 0; nt < 8; ++nt) { const bf16x8 B = *(const bf16x8*)(VT + (16 * nt + fr) * 136 + ks * 32 + fq * 8); O[nt] = MFMA16(A, B, O[nt]); }
        }
#pragma unroll
        for (int i = 0; i < 4; ++i) {
            const float den = si[i] * den1[i] + den2[i];
            const float dn = fmaxf(fabsf(den), __expf(-(BC[d * 128 + trow + i] + Mt[i])));
            const float inv = 1.0f / dn;
#pragma unroll
            for (int nt = 0; nt < 8; ++nt) hsum[nt][i] += O[nt][i] * inv;
        }
        __syncthreads();
    }
    const float* gain = a.in[19] + h * 128;
#pragma unroll
    for (int i = 0; i < 4; ++i) {
        float ss = 0.f;
#pragma unroll
        for (int nt = 0; nt < 8; ++nt) ss += hsum[nt][i] * hsum[nt][i];
        ss += __shfl_xor(ss, 1); ss += __shfl_xor(ss, 2); ss += __shfl_xor(ss, 4); ss += __shfl_xor(ss, 8);
        const float rinv = 1.0f / sqrtf(ss * (1.0f / 128.0f) + EPS);
        const size_t row = (size_t)mrow_lat(b, c * 128 + trow + i);
#pragma unroll
        for (int nt = 0; nt < 8; ++nt) { const int v = 16 * nt + fr;
            const float o = bf2f(P[row * DINP + PC_O + h * 128 + v]);
            YA[row * D + 1024 + h * 128 + v] = f2bf(hsum[nt][i] * rinv * gain[v] * sigmoidf_(o)); }
    }
    __syncthreads();
}

#ifndef STAGE
#define STAGE 99
#endif
__global__ void __launch_bounds__(NTHR, 2) mega(Args a) {
    extern __shared__ __attribute__((aligned(16))) unsigned char lds[];
    cg::grid_group grid = cg::this_grid();
    const int tid = threadIdx.x, lane = tid & 63, wave = __builtin_amdgcn_readfirstlane(tid >> 6);
    const int G = gridDim.x, gw = blockIdx.x * 8 + wave, NGW = G * 8;
    unsigned char* ws = a.ws;
    float* mod = (float*)(ws + WS_MOD);
    bf16_t* XN = (bf16_t*)(ws + WS_XN);
    bf16_t* ACT = (bf16_t*)(ws + WS_ACT);
    bf16_t* P = (bf16_t*)(ws + WS_ACT);
    float* X = (float*)(ws + WS_X);
    PG8_LAS unsigned char* ldsl = (PG8_LAS unsigned char*)lds;

    phase0(a, lds, tid, lane, wave);
    grid.sync();
    norm_mod_rows(a.in[0], a.in[2], MT, a.in[6], mod, 0, XN, gw, NGW, lane);
    grid.sync();
    { pg8::Gemm g{XN, (const bf16_t*)(ws + WS_WUP1), MT, 2 * DFF, D}; pg8::StaticOrder S; S.init(MT, 2 * DFF, G, (int)blockIdx.x);
      EpiSwiglu E{ACT, DFF}; pg8::gemm_phase<EpiSwiglu, pg8::StaticOrder, true, true>(ldsl, g, S, E); }
    grid.sync();
    { pg8::Gemm g{ACT, (const bf16_t*)(ws + WS_WDN1), MT, D, DFF}; pg8::StaticOrder S; S.init(MT, D, G, (int)blockIdx.x);
      EpiResid E{a.in[0], a.in[2], X, mod, 2 * D, 0.5f}; pg8::gemm_phase<EpiResid, pg8::StaticOrder, true, true>(ldsl, g, S, E); }
    grid.sync();
#if STAGE >= 2
    norm_mod_rows(X, X + (size_t)ML * D, MT, a.in[9], mod, 1, XN, gw, NGW, lane);
    grid.sync();
    { pg8::Gemm g{XN, (const bf16_t*)(ws + WS_WIN), MT, DINP, D}; pg8::StaticOrder S; S.init(MT, DINP, G, (int)blockIdx.x);
      EpiInProj E{P, (float*)(ws + WS_G), a.in[11]}; pg8::gemm_phase<EpiInProj, pg8::StaticOrder, true, true>(ldsl, g, S, E); }
    grid.sync();
    for (int it = blockIdx.x; it < 1088 + 544; it += G) {
        if (it < 1088) lru_local_item(lds, it, a, tid, lane, wave);
        else mlstm_local_item(lds, it - 1088, a, tid, lane, wave);
    }
    grid.sync();
    lru_carry(a, blockIdx.x * NTHR + tid, G * NTHR);
    mlstm_state_scan(a, blockIdx.x * NTHR + tid, G * NTHR);
    grid.sync();
    for (int it = blockIdx.x; it < 512; it += G) mlstm_out_item(lds, it, a, tid, lane, wave);
    lru_combine_rows(a, gw, NGW, lane);
    grid.sync();
    { pg8::Gemm g{(const bf16_t*)(ws + WS_YA), (const bf16_t*)(ws + WS_WOUT), ML, D, D}; pg8::StaticOrder S; S.init(ML, D, G, (int)blockIdx.x);
      EpiResid E{X, X, X, mod, 5 * D, 1.0f}; pg8::gemm_phase<EpiResid, pg8::StaticOrder, true, true>(ldsl, g, S, E); }
    grid.sync();
#endif
#if STAGE >= 3
    norm_mod_rows(X, X, ML, a.in[21], mod, 2, XN, gw, NGW, lane);
    grid.sync();
    { pg8::Gemm g{XN, (const bf16_t*)(ws + WS_WUP2), ML, 2 * DFF, D}; pg8::StaticOrder S; S.init(ML, 2 * DFF, G, (int)blockIdx.x);
      EpiSwiglu E{ACT, DFF}; pg8::gemm_phase<EpiSwiglu, pg8::StaticOrder, true, true>(ldsl, g, S, E); }
    grid.sync();
    { pg8::Gemm g{ACT, (const bf16_t*)(ws + WS_WDN2), ML, D, DFF}; pg8::StaticOrder S; S.init(ML, D, G, (int)blockIdx.x);
      EpiResid E{X, X, X, mod, 8 * D, 0.5f}; pg8::gemm_phase<EpiResid, pg8::StaticOrder, true, true>(ldsl, g, S, E); }
    grid.sync();
#endif
    final_norm_rows(X, a.in[24], a.out, gw, NGW, lane);
}

extern "C" void kernel_launch(void* const* d_in, const int* in_sizes, int n_in, void* d_out, int out_size, void* d_ws, size_t ws_size, hipStream_t stream) {
    static int grid = 0;
    if (grid == 0) {
        if (n_in != 25 || out_size != ML * D || ws_size < WS_END) { fprintf(stderr, "kernel_launch: unexpected shapes (n_in %d out %d ws %zu)\n", n_in, out_size, ws_size); grid = -1; return; }
        int dev = 0, cus = 0, per_cu = 0;
        hipGetDevice(&dev);
        hipDeviceGetAttribute(&cus, hipDeviceAttributeMultiprocessorCount, dev);
        hipFuncSetAttribute((const void*)mega, hipFuncAttributeMaxDynamicSharedMemorySize, LDS_BYTES);
        hipOccupancyMaxActiveBlocksPerMultiprocessor(&per_cu, (const void*)mega, NTHR, LDS_BYTES);
        if (per_cu < 1) fprintf(stderr, "kernel_launch: occupancy query says %d blocks per CU\n", per_cu);
        (void)hipGetLastError();
        grid = cus;
    }
    if (grid < 0) return;
    Args a{};
    for (int i = 0; i < 25; ++i) a.in[i] = (const float*)d_in[i];
    a.out = (float*)d_out; a.ws = (unsigned char*)d_ws;
    void* args[] = {&a};
    hipError_t e = hipLaunchCooperativeKernel((const void*)mega, dim3(grid), dim3(NTHR), args, LDS_BYTES, stream);
    if (e != hipSuccess) fprintf(stderr, "cooperative launch failed: %s (grid %d)\n", hipGetErrorString(e), grid);
}
```

```cpp
#include <hip/hip_runtime.h>
#include <hip/hip_cooperative_groups.h>
#include <cstdio>
#include <cstdint>
namespace cg = cooperative_groups;
#define STAGE 99
#define PROBE 0
namespace pg8 {
#define PG8_LAS __attribute__((address_space(3)))
typedef unsigned short bf16_t;
typedef short bf16x8 __attribute__((ext_vector_type(8)));
typedef float f32x4 __attribute__((ext_vector_type(4)));
typedef unsigned u32x4 __attribute__((ext_vector_type(4)));
constexpr int BM = 256, BK = 64, HALF = 128, HTB = HALF * BK * 2  , STAGE_BYTES = 8 * HTB, NXCD = 8, WGM = 8;

__host__ __device__ __forceinline__ int lds_byte(int r, int c) { const int st = (r >> 4) * 2 + (c >> 5), rr = r & 15, cc = c & 31, ob = rr * 64 + cc * 2; return st * 1024 + (ob ^ (((ob >> 9) & 1) << 5)); }
__host__ __device__ __forceinline__ void stage_rc(int b, int& R, int& C) { const int st = b / 1024, sb = b % 1024, swz = sb ^ (((sb >> 9) & 1) << 5); R = (st >> 1) * 16 + swz / 64; C = (st & 1) * 32 + (swz % 64) / 2; }
__host__ __device__ __forceinline__ int perm32(int rho) { const int n = rho >> 4, i = rho & 15; return 8 * (i >> 2) + 4 * n + (i & 3); }

struct Unit { int pm, pn; };
struct Gemm { const bf16_t* A; const bf16_t* Bt; int M, N, K; };

struct StaticOrder {
    int nM, nN, nwg, G, c;
    __host__ __device__ void init(int M, int N, int G_, int c_) { nM = M / BM; nN = N / BM; nwg = nM * nN; G = G_; c = c_; }
    __host__ __device__ bool next(int i, Unit& u) const {
        const long L = (long)i * G + c; if (L >= nwg) return false;
        int wgid = (int)L; { const int q = nwg / NXCD, r = nwg % NXCD, xcd = wgid % NXCD, off = wgid / NXCD; wgid = (xcd < r ? xcd * (q + 1) : r * (q + 1) + (xcd - r) * q) + off; }
        const int nig = WGM * nN, gid = wgid / nig, fm = gid * WGM, gsz = (nM - fm) < WGM ? (nM - fm) : WGM;
        u.pm = fm + ((wgid % nig) % gsz); u.pn = (wgid % nig) / gsz; return true;
    }
    __device__ __forceinline__ void a_ready(const Unit&) const {}
    __device__ __forceinline__ void done(const Unit&) const {}
};

__device__ __forceinline__ unsigned cvt_pk_bf16(float lo, float hi) { unsigned r; asm volatile("v_cvt_pk_bf16_f32 %0, %1, %2" : "=v"(r) : "v"(lo), "v"(hi)); return r; }
typedef float f32x2 __attribute__((ext_vector_type(2)));
__device__ __forceinline__ f32x2 gelu_pk(f32x2 v) {
    const f32x2 av = __builtin_elementwise_abs(v), d = av * 0.2316418882f + 1.0f;
    f32x2 t; t.x = __builtin_amdgcn_rcpf(d.x); t.y = __builtin_amdgcn_rcpf(d.y);
    f32x2 q = t * 0.5307027145f + (-0.7265760135f); q = q * t + 0.7107068705f; q = q * t + (-0.142248368f); q = q * t + 0.127414796f; q = q * t;
    const f32x2 s = (v * v) * (-0.72134752044f);
    f32x2 e; e.x = __builtin_amdgcn_exp2f(s.x); e.y = __builtin_amdgcn_exp2f(s.y);
    const f32x2 m = v * (q * e), r = v - m;
    f32x2 o; o.x = v.x < 0.f ? m.x : r.x; o.y = v.y < 0.f ? m.y : r.y; return o;
}

template <class Epi, class Sched, bool ALIGN_EPI = false, bool SP2 = false>
__device__ __forceinline__ void gemm_phase(PG8_LAS unsigned char* lds, const Gemm g, const Sched& S, const Epi& E) {
    const int tid = threadIdx.x, wid = __builtin_amdgcn_readfirstlane(tid >> 6), lane = tid & 63, wr = wid >> 2, wc = wid & 3, fr = lane & 15, fq = lane >> 4;
    const int K = g.K, nt = K / BK;
    unsigned voffA[2], voffB[2];
#pragma unroll
    for (int i = 0; i < 2; ++i) { int R, C; stage_rc(tid * 16 + i * 8192, R, C); const int Rb = Epi::PERM ? ((R & ~31) + perm32(R & 31)) : R;
        voffA[i] = (unsigned)(R * K + C) * 2u; voffB[i] = (unsigned)(Rb * K + C) * 2u; }
    const size_t kstep = (size_t)(BK * 2);
    const size_t hstep = (size_t)HALF * K * 2;
    const size_t tstep = 2 * hstep;
    const unsigned ldsw = (unsigned)wid * 1024u;
    const int aoff = lds_byte(wr * 64 + fr, fq * 8), boff = lds_byte(wc * 32 + fr, fq * 8);
#define PG8_SA(b, h) (((b) * 2 + (h)) * HTB)
#define PG8_SB(b, h) ((4 + (b) * 2 + (h)) * HTB)
#define PG8_STAGE(bufoff, gbase, voff) do { _Pragma("unroll") for (int _i = 0; _i < 2; ++_i) \
        __builtin_amdgcn_global_load_lds((const unsigned*)((const char*)(gbase) + (voff)[_i]), (PG8_LAS unsigned*)(lds + (bufoff) + ldsw + _i * 8192), 16, 0, 0); } while (0)
#define PG8_LDA(dst, b, h) do { _Pragma("unroll") for (int m = 0; m < 4; ++m) _Pragma("unroll") for (int k = 0; k < 2; ++k) dst[m][k] = *(const PG8_LAS bf16x8*)(lds + PG8_SA(b, h) + aoff + m * 2048 + k * 1024); } while (0)
#define PG8_LDB(dst, b, h) do { _Pragma("unroll") for (int n = 0; n < 2; ++n) _Pragma("unroll") for (int k = 0; k < 2; ++k) dst[n][k] = *(const PG8_LAS bf16x8*)(lds + PG8_SB(b, h) + boff + n * 2048 + k * 1024); } while (0)
#define PG8_MMA(ai, bj, At, Bt) do { __builtin_amdgcn_s_setprio(1); _Pragma("unroll") for (int m = 0; m < 4; ++m) _Pragma("unroll") for (int n = 0; n < 2; ++n) _Pragma("unroll") for (int k = 0; k < 2; ++k) \
        acc[ai][bj][m][n] = __builtin_amdgcn_mfma_f32_16x16x32_bf16(Bt[n][k], At[m][k], acc[ai][bj][m][n], 0, 0, 0); __builtin_amdgcn_s_setprio(0); } while (0)
#define PG8_WAIT_V(n) asm volatile("s_waitcnt vmcnt(" #n ")" ::: "memory")
#define PG8_WAIT_L(n) asm volatile("s_waitcnt lgkmcnt(" #n ")" ::: "memory")
#define PG8_BAR __builtin_amdgcn_s_barrier()
#define PG8_SCHED __builtin_amdgcn_sched_barrier(0)
    Unit cur, nxt; int ui = 0;
    if (!S.next(0, cur)) return;
    f32x4 acc[2][2][4][2];
#pragma unroll
    for (int a = 0; a < 2; ++a)
#pragma unroll
        for (int b = 0; b < 2; ++b)
#pragma unroll
            for (int m = 0; m < 4; ++m)
#pragma unroll
                for (int n = 0; n < 2; ++n) acc[a][b][m][n] = (f32x4){0.f, 0.f, 0.f, 0.f};
    bf16x8 At[4][2], B0[2][2], B1[2][2];
    const char* cA = (const char*)g.A + (size_t)cur.pm * tstep; const char* cB = (const char*)g.Bt + (size_t)cur.pn * tstep;
    S.a_ready(cur);
    if constexpr (SP2) {
        PG8_STAGE(PG8_SB(0, 0), cB, voffB); PG8_STAGE(PG8_SB(0, 1), cB + hstep, voffB); PG8_STAGE(PG8_SA(0, 0), cA, voffA); PG8_STAGE(PG8_SA(0, 1), cA + hstep, voffA);
        if (wr == 1) PG8_BAR;
        PG8_WAIT_V(2); PG8_BAR;
        PG8_STAGE(PG8_SB(1, 0), cB + kstep, voffB); PG8_STAGE(PG8_SA(1, 0), cA + kstep, voffA); PG8_STAGE(PG8_SB(1, 1), cB + hstep + kstep, voffB);
        PG8_WAIT_V(6); PG8_BAR;
    } else {
        PG8_STAGE(PG8_SB(0, 0), cB, voffB); PG8_STAGE(PG8_SA(0, 0), cA, voffA); PG8_STAGE(PG8_SB(0, 1), cB + hstep, voffB); PG8_STAGE(PG8_SA(0, 1), cA + hstep, voffA);
        if (wr == 1) PG8_BAR;
        PG8_WAIT_V(4); PG8_BAR;
        PG8_STAGE(PG8_SB(1, 0), cB + kstep, voffB); PG8_STAGE(PG8_SA(1, 0), cA + kstep, voffA); PG8_STAGE(PG8_SB(1, 1), cB + hstep + kstep, voffB);
        PG8_WAIT_V(6); PG8_BAR;
    }
    for (;;) {
        const bool has_next = S.next(ui + 1, nxt);
        const char* nA = has_next ? (const char*)g.A + (size_t)nxt.pm * tstep : cA; const char* nB = has_next ? (const char*)g.Bt + (size_t)nxt.pn * tstep : cB;
        for (int t = 0; t < nt; t += 2) {
            const bool last = (t == nt - 2);
            const char* a1 = cA + (size_t)(t + 1) * kstep;
            const char* a2 = last ? nA : cA + (size_t)(t + 2) * kstep; const char* b2 = last ? nB : cB + (size_t)(t + 2) * kstep;
            const char* a3 = a2 + kstep; const char* b3 = b2 + kstep;
            if (last && has_next) S.a_ready(nxt);
            if constexpr (SP2) {
            PG8_LDB(B0, 0, 0); PG8_LDB(B1, 0, 1); PG8_SCHED; PG8_LDA(At, 0, 0); PG8_STAGE(PG8_SA(1, 1), a1 + hstep, voffA);
            PG8_WAIT_V(8); PG8_WAIT_L(0); PG8_BAR; PG8_MMA(0, 0, At, B0); PG8_MMA(0, 1, At, B1); PG8_BAR; PG8_SCHED;
            PG8_LDA(At, 0, 1); PG8_STAGE(PG8_SB(0, 0), b2, voffB); PG8_STAGE(PG8_SB(0, 1), b2 + hstep, voffB); PG8_STAGE(PG8_SA(0, 0), a2, voffA);
            PG8_WAIT_V(8); PG8_WAIT_L(0); PG8_BAR; PG8_MMA(1, 0, At, B0); PG8_MMA(1, 1, At, B1); PG8_BAR; PG8_SCHED;
            PG8_LDB(B0, 1, 0); PG8_LDB(B1, 1, 1); PG8_SCHED; PG8_LDA(At, 1, 0); PG8_STAGE(PG8_SA(0, 1), a2 + hstep, voffA);
            PG8_WAIT_V(8); PG8_WAIT_L(0); PG8_BAR; PG8_MMA(0, 0, At, B0); PG8_MMA(0, 1, At, B1); PG8_BAR; PG8_SCHED;
            PG8_LDA(At, 1, 1); PG8_STAGE(PG8_SB(1, 0), b3, voffB); PG8_STAGE(PG8_SB(1, 1), b3 + hstep, voffB); PG8_STAGE(PG8_SA(1, 0), a3, voffA);
            PG8_WAIT_V(8); PG8_WAIT_L(0); PG8_BAR; PG8_MMA(1, 0, At, B0); PG8_MMA(1, 1, At, B1); PG8_BAR; PG8_SCHED;
            } else {
            PG8_LDB(B0, 0, 0); PG8_SCHED; PG8_LDA(At, 0, 0); PG8_STAGE(PG8_SA(1, 1), a1 + hstep, voffA);
            PG8_WAIT_L(8); PG8_BAR; PG8_WAIT_L(0); PG8_MMA(0, 0, At, B0); PG8_BAR; PG8_SCHED;
            PG8_LDB(B1, 0, 1); PG8_STAGE(PG8_SB(0, 0), b2, voffB);
            PG8_BAR; PG8_WAIT_L(0); PG8_MMA(0, 1, At, B1); PG8_BAR;
            PG8_LDA(At, 0, 1); PG8_STAGE(PG8_SA(0, 0), a2, voffA);
            PG8_BAR; PG8_WAIT_L(0); PG8_MMA(1, 0, At, B0); PG8_BAR; PG8_SCHED;
            PG8_STAGE(PG8_SB(0, 1), b2 + hstep, voffB);
            PG8_WAIT_V(6); PG8_BAR; PG8_MMA(1, 1, At, B1); PG8_BAR;
            PG8_LDB(B0, 1, 0); PG8_SCHED; PG8_LDA(At, 1, 0); PG8_STAGE(PG8_SA(0, 1), a2 + hstep, voffA);
            PG8_WAIT_L(8); PG8_BAR; PG8_WAIT_L(0); PG8_MMA(0, 0, At, B0); PG8_BAR; PG8_SCHED;
            PG8_LDB(B1, 1, 1); PG8_STAGE(PG8_SB(1, 0), b3, voffB);
            PG8_BAR; PG8_WAIT_L(0); PG8_MMA(0, 1, At, B1); PG8_BAR;
            PG8_LDA(At, 1, 1); PG8_STAGE(PG8_SA(1, 0), a3, voffA);
            PG8_BAR; PG8_WAIT_L(0); PG8_MMA(1, 0, At, B0); PG8_BAR; PG8_SCHED;
            PG8_STAGE(PG8_SB(1, 1), b3 + hstep, voffB);
            PG8_WAIT_V(6); PG8_BAR; PG8_MMA(1, 1, At, B1); PG8_BAR;
            }
        }
        if constexpr (ALIGN_EPI) { if (wr == 0) PG8_BAR; }
        if constexpr (!Epi::AFTER_DRAIN) { E(acc, cur, wr, wc, fr, fq); S.done(cur); }
        if (!has_next) break;
#pragma unroll
        for (int a = 0; a < 2; ++a)
#pragma unroll
            for (int b = 0; b < 2; ++b)
#pragma unroll
                for (int m = 0; m < 4; ++m)
#pragma unroll
                    for (int n = 0; n < 2; ++n) acc[a][b][m][n] = (f32x4){0.f, 0.f, 0.f, 0.f};
        cur = nxt; cA = nA; cB = nB; ++ui;
        if constexpr (ALIGN_EPI) { if (wr == 1) PG8_BAR; }
    }
    PG8_WAIT_V(0);
    if constexpr (!ALIGN_EPI) { if (wr == 0) PG8_BAR; }
    PG8_BAR;
    if constexpr (Epi::AFTER_DRAIN) { E.fused(acc, cur, wr, wc, fr, fq, lds, wid, lane); S.done(cur); }
#undef PG8_SA
#undef PG8_SB
#undef PG8_STAGE
#undef PG8_LDA
#undef PG8_LDB
#undef PG8_MMA
#undef PG8_WAIT_V
#undef PG8_WAIT_L
#undef PG8_BAR
#undef PG8_SCHED
}
}
#define LAS __attribute__((address_space(3)))
#define XB_TMO      128
#define XB_XCNT(j)  (256  + 64 * (j))
#define XB_XSUB(j)  (1280 + 64 * (j))
#define XB_XGEN(j)  (2304 + 64 * (j))
#define XB_TOP      3328
#define XB_TOPGEN   3392
#define XCD_BAR_WORDS 3456
#define XB_SPIN_CAP (1u << 18)

__device__ __forceinline__ unsigned xb_ld(unsigned* p)              { return __hip_atomic_load(p, __ATOMIC_RELAXED, __HIP_MEMORY_SCOPE_AGENT); }
__device__ __forceinline__ unsigned xb_add(unsigned* p, unsigned v) { return __hip_atomic_fetch_add(p, v, __ATOMIC_RELAXED, __HIP_MEMORY_SCOPE_AGENT); }
__device__ __forceinline__ unsigned xb_xcc_id() { return (unsigned)__builtin_amdgcn_s_getreg((3 << 11) | 20) & 0xFu; }
#define XB_SPIN(cond, bar) do { unsigned _sp = 0; while (cond) { __builtin_amdgcn_s_sleep(1); \
    if ((++_sp & 255u) == 0u) { if (xb_ld(&(bar)[XB_TMO])) break; if (_sp > XB_SPIN_CAP) { atomicAdd(&(bar)[XB_TMO], 1u); break; } } } } while (0)

struct XcdBarrier {
    unsigned* bar; unsigned x;
    volatile LAS unsigned* st;
};

__device__ __forceinline__ XcdBarrier xcd_barrier_post(unsigned* bar, volatile LAS unsigned* st) {
    XcdBarrier b; b.bar = bar; b.x = xb_xcc_id(); b.st = st;
    if (threadIdx.x == 0) (void)xb_add(&bar[XB_XCNT(b.x)], 1u);
    return b;
}
__device__ __forceinline__ void xcd_barrier_complete(unsigned* bar, unsigned x, unsigned& nloc, unsigned& nx) {
    const unsigned G = gridDim.x * gridDim.y * gridDim.z;
    unsigned sum, cnt, mine, sp = 0u;
    for (;;) {
        sum = 0u; cnt = 0u; mine = 0u;
#pragma unroll
        for (unsigned j = 0; j < 16; ++j) { const unsigned c = xb_ld(&bar[XB_XCNT(j)]); sum += c; cnt += (c > 0u) ? 1u : 0u; mine = (j == x) ? c : mine; }
        if (sum == G) break;
        __builtin_amdgcn_s_sleep(1);
        if ((++sp & 255u) == 0u) { if (xb_ld(&bar[XB_TMO])) break; if (sp > XB_SPIN_CAP) { atomicAdd(&bar[XB_TMO], 1u); break; } }
    }
    nloc = mine > 0u ? mine : 1u; nx = cnt > 0u ? cnt : 1u;
}

__device__ __forceinline__ void xcd_barrier(const XcdBarrier& b) {
    asm volatile("s_waitcnt vmcnt(0)" ::: "memory");
    __syncthreads();
    if (threadIdx.x == 0) {
        unsigned* bar = b.bar;
        __builtin_amdgcn_s_waitcnt(0);
        unsigned nloc = b.st[0], nx = b.st[1];
        if (nloc == 0u) { xcd_barrier_complete(bar, b.x, nloc, nx); b.st[0] = nloc; b.st[1] = nx; }
        const unsigned old = xb_add(&bar[XB_XSUB(b.x)], 1u);
        const unsigned gen = old / nloc;
        if (old + 1u == (gen + 1u) * nloc) {
            __builtin_amdgcn_fence(__ATOMIC_RELEASE, "agent");
            asm volatile("s_waitcnt vmcnt(0)" ::: "memory");
            const unsigned og = xb_add(&bar[XB_TOP], 1u);
            const unsigned tg = og / nx;
            if (og + 1u == (tg + 1u) * nx) xb_add(&bar[XB_TOPGEN], 1u);
            else XB_SPIN(xb_ld(&bar[XB_TOPGEN]) == tg, bar);
            __builtin_amdgcn_fence(__ATOMIC_ACQUIRE, "agent");
            xb_add(&bar[XB_XGEN(b.x)], 1u);
            asm volatile("s_waitcnt vmcnt(0)" ::: "memory");
        } else {
            XB_SPIN(xb_ld(&bar[XB_XGEN(b.x)]) == gen, bar);
            __builtin_amdgcn_fence(__ATOMIC_ACQUIRE, "agent");
            asm volatile("s_waitcnt vmcnt(0)" ::: "memory");
        }
    }
    __syncthreads();
}
using pg8::bf16_t; using pg8::bf16x8; using pg8::f32x4; using pg8::u32x4;

constexpr int NTHR = 512, LDS_BYTES = 147456;
constexpr int D = 2048, SEQ = 4096, BATCH = 2, CTXL = 256, DFF = 5632, DIN = 5152, DINP = 5376;
constexpr int ML = BATCH * SEQ, MC = BATCH * CTXL, MT = ML + MC;
constexpr int NMOD = 9 * D;
constexpr float EPS = 1e-6f;
constexpr int PC_LX = 0, PC_LG = 1024, PC_Q = 2048, PC_K = 2560, PC_V = 3072, PC_O = 4096, PC_GT = 5120;
constexpr size_t MiB = 1u << 20;
constexpr size_t WS_MOD = 0, WS_WG = 1 * MiB, WS_WUP1 = 2 * MiB, WS_WDN1 = 46 * MiB, WS_WIN = 68 * MiB, WS_WOUT = 89 * MiB, WS_WUP2 = 97 * MiB, WS_WDN2 = 141 * MiB,
    WS_XN = 163 * MiB, WS_ACT = 197 * MiB  , WS_X = 291 * MiB, WS_G = 359 * MiB, WS_HL = 361 * MiB, WS_AC = 393 * MiB,
    WS_CSUM = 425 * MiB, WS_CARRY = 428 * MiB, WS_CST = 429 * MiB, WS_MSC = 464 * MiB, WS_YA = 465 * MiB, WS_CPREV = 497 * MiB, WS_END = 530 * MiB;
constexpr int CSTE = 8256;

struct Args { const float* in[25]; float* out; unsigned char* ws; int never, pad; };
constexpr size_t WS_BAR = WS_MOD + 512 * 1024;

__device__ __forceinline__ unsigned pk2(float lo, float hi) { return pg8::cvt_pk_bf16(lo, hi); }
__device__ __forceinline__ unsigned short f2bf(float f) { return (unsigned short)(pg8::cvt_pk_bf16(f, 0.f) & 0xffffu); }
__device__ __forceinline__ float bflo(unsigned w) { return __uint_as_float(w << 16); }
__device__ __forceinline__ float bfhi(unsigned w) { return __uint_as_float(w & 0xffff0000u); }
__device__ __forceinline__ float bf2f(unsigned short h) { return __uint_as_float((unsigned)h << 16); }
__device__ __forceinline__ float sigmoidf_(float x) { return 1.0f / (1.0f + __expf(-x)); }
__device__ __forceinline__ float siluf_(float x) { return x / (1.0f + __expf(-x)); }
__device__ __forceinline__ float logsigmoidf_(float x) { return fminf(x, 0.f) - log1pf(__expf(-fabsf(x))); }
__device__ __forceinline__ float gelu_tanhf_(float x) { const float u = 0.7978845608028654f * (x + 0.044715f * x * x * x); return 0.5f * x * (1.0f + tanhf(u)); }
__device__ __forceinline__ float wave_sum(float v) {
#pragma unroll
    for (int o = 1; o < 64; o <<= 1) v += __shfl_xor(v, o);
    return v;
}
__device__ __forceinline__ float wave_max(float v) {
#pragma unroll
    for (int o = 1; o < 64; o <<= 1) v = fmaxf(v, __shfl_xor(v, o));
    return v;
}
__device__ __forceinline__ float wave_incl_sum(float v, int lane) {
#pragma unroll
    for (int o = 1; o < 64; o <<= 1) { const float t = __shfl_up(v, o); if (lane >= o) v += t; }
    return v;
}
__device__ __forceinline__ float wave_incl_max(float v, int lane) {
#pragma unroll
    for (int o = 1; o < 64; o <<= 1) { const float t = __shfl_up(v, o); if (lane >= o) v = fmaxf(v, t); }
    return v;
}
__device__ __forceinline__ bf16x8 pack8(const float* p) {
    const f32x4 a = *(const f32x4*)p, b = *(const f32x4*)(p + 4);
    u32x4 w; w.x = pk2(a.x, a.y); w.y = pk2(a.z, a.w); w.z = pk2(b.x, b.y); w.w = pk2(b.z, b.w);
    return __builtin_bit_cast(bf16x8, w);
}
#define MFMA16(a, b, c) __builtin_amdgcn_mfma_f32_16x16x32_bf16((a), (b), (c), 0, 0, 0)

struct EpiSwiglu {
    static constexpr bool PERM = true, AFTER_DRAIN = false;
    bf16_t* O; int ldc;
    __device__ __forceinline__ void operator()(const f32x4 (&acc)[2][2][4][2], const pg8::Unit& u, int wr, int wc, int fr, int fq) const {
        const int row0 = u.pm * 256 + wr * 64 + fr, col0 = u.pn * 128 + wc * 32 + 8 * fq;
#pragma unroll
        for (int ai = 0; ai < 2; ++ai)
#pragma unroll
            for (int m = 0; m < 4; ++m) {
                bf16_t* rowp = O + (size_t)(row0 + ai * 128 + m * 16) * ldc + col0;
                const f32x4 g0 = acc[ai][0][m][0], g1 = acc[ai][0][m][1], u0 = acc[ai][1][m][0], u1 = acc[ai][1][m][1];
                u32x4 w;
                w.x = pk2(siluf_(g0[0]) * u0[0], siluf_(g0[1]) * u0[1]); w.y = pk2(siluf_(g0[2]) * u0[2], siluf_(g0[3]) * u0[3]);
                w.z = pk2(siluf_(g1[0]) * u1[0], siluf_(g1[1]) * u1[1]); w.w = pk2(siluf_(g1[2]) * u1[2], siluf_(g1[3]) * u1[3]);
                *(u32x4*)rowp = w;
            }
    }
};
struct EpiResid {
    static constexpr bool PERM = false, AFTER_DRAIN = false;
    const float* baseL; const float* baseC; float* out; const float* mod; int goff; float scale;
    __device__ __forceinline__ void operator()(const f32x4 (&acc)[2][2][4][2], const pg8::Unit& u, int wr, int wc, int fr, int fq) const {
        const int rowt = u.pm * 256; const int mr = rowt < ML ? (rowt >> 12) : 2;
        const float* bp = rowt < ML ? baseL : baseC - (size_t)ML * D;
        const float* gp = mod + (size_t)mr * NMOD + goff;
        const int col0 = u.pn * 256 + wc * 32 + 4 * fq;
#pragma unroll
        for (int bj = 0; bj < 2; ++bj)
#pragma unroll
            for (int n = 0; n < 2; ++n) {
                const int c = col0 + bj * 128 + n * 16;
                const f32x4 gv = *(const f32x4*)(gp + c) * scale;
#pragma unroll
                for (int ai = 0; ai < 2; ++ai)
#pragma unroll
                    for (int m = 0; m < 4; ++m) {
                        const size_t off = (size_t)(rowt + ai * 128 + wr * 64 + m * 16 + fr) * D + c;
                        const f32x4 bs = *(const f32x4*)(bp + off);
                        *(f32x4*)(out + off) = bs + gv * acc[ai][bj][m][n];
                    }
                asm volatile("" ::: "memory");
            }
    }
};
struct EpiInProj {
    static constexpr bool PERM = true, AFTER_DRAIN = false;
    bf16_t* P; float* G; const float* bm;
    __device__ __forceinline__ void operator()(const f32x4 (&acc)[2][2][4][2], const pg8::Unit& u, int wr, int wc, int fr, int fq) const {
        const int row0 = u.pm * 256 + wr * 64 + fr, col0 = u.pn * 256 + wc * 32 + 8 * fq;
        const bool gates = (u.pn == PC_GT / 256) && (wc == 0);
#pragma unroll
        for (int ai = 0; ai < 2; ++ai)
#pragma unroll
            for (int m = 0; m < 4; ++m) {
                const int row = row0 + ai * 128 + m * 16;
                bf16_t* rowp = P + (size_t)row * DINP + col0;
#pragma unroll
                for (int bj = 0; bj < 2; ++bj) {
                    const f32x4 v0 = acc[ai][bj][m][0], v1 = acc[ai][bj][m][1];
                    u32x4 w; w.x = pk2(v0[0], v0[1]); w.y = pk2(v0[2], v0[3]); w.z = pk2(v1[0], v1[1]); w.w = pk2(v1[2], v1[3]);
                    *(u32x4*)(rowp + bj * 128) = w;
                }
                if (gates) {
                    const f32x4 b0 = *(const f32x4*)(bm + 8 * fq), b1 = *(const f32x4*)(bm + 8 * fq + 4);
                    *(f32x4*)(G + (size_t)row * 32 + 8 * fq) = acc[ai][0][m][0] + b0;
                    *(f32x4*)(G + (size_t)row * 32 + 8 * fq + 4) = acc[ai][0][m][1] + b1;
                }
            }
    }
};

__device__ __forceinline__ void transpose_item(const float* __restrict__ W, int K, int N, bf16_t* __restrict__ WT, int k0, int n0, int drow0, float* scr, int lane) {
#pragma unroll 8
    for (int i = 0; i < 32; ++i) { const int kk = 2 * i + (lane >> 5); scr[kk * 33 + (lane & 31)] = W[(size_t)(k0 + kk) * N + n0 + (lane & 31)]; }
    __builtin_amdgcn_s_waitcnt(0); asm volatile("" ::: "memory");
    const int c = lane & 7;
#pragma unroll
    for (int j = 0; j < 4; ++j) { const int n = (lane >> 3) + 8 * j; const float* s = scr + (8 * c) * 33 + n;
        u32x4 o; o.x = pk2(s[0 * 33], s[1 * 33]); o.y = pk2(s[2 * 33], s[3 * 33]); o.z = pk2(s[4 * 33], s[5 * 33]); o.w = pk2(s[6 * 33], s[7 * 33]);
        *(u32x4*)(WT + (size_t)(drow0 + n) * K + k0 + 8 * c) = o; }
    __builtin_amdgcn_s_waitcnt(0); asm volatile("" ::: "memory");
}
__device__ __forceinline__ int swiglu_row(int n0) {
    return n0 < DFF ? 256 * (n0 >> 7) + (n0 & 127) : 256 * ((n0 - DFF) >> 7) + 128 + ((n0 - DFF) & 127);
}
constexpr int T_UP = 32 * 352, T_DN = 88 * 64, T_IN = 32 * 161, T_OUT = 32 * 64, T_G = 256;
constexpr int T_ALL = 2 * T_UP + 2 * T_DN + T_IN + T_OUT + T_G;
__device__ __forceinline__ void p0_item(const Args& a, int it, float* scr, int lane) {
    unsigned char* ws = a.ws;
    if (it < 2 * T_UP) { const int w = it >= T_UP; const int r = it - w * T_UP; const int kb = r / 352, nb = r % 352;
        transpose_item(a.in[w ? 22 : 7], D, 2 * DFF, (bf16_t*)(ws + (w ? WS_WUP2 : WS_WUP1)), 64 * kb, 32 * nb, swiglu_row(32 * nb), scr, lane); return; }
    it -= 2 * T_UP;
    if (it < 2 * T_DN) { const int w = it >= T_DN; const int r = it - w * T_DN; const int kb = r / 64, nb = r % 64;
        transpose_item(a.in[w ? 23 : 8], DFF, D, (bf16_t*)(ws + (w ? WS_WDN2 : WS_WDN1)), 64 * kb, 32 * nb, 32 * nb, scr, lane); return; }
    it -= 2 * T_DN;
    if (it < T_IN) { const int kb = it / 161, nb = it % 161; transpose_item(a.in[10], D, DIN, (bf16_t*)(ws + WS_WIN), 64 * kb, 32 * nb, 32 * nb, scr, lane); return; }
    it -= T_IN;
    if (it < T_OUT) { const int kb = it / 64, nb = it % 64; transpose_item(a.in[20], D, D, (bf16_t*)(ws + WS_WOUT), 64 * kb, 32 * nb, 32 * nb, scr, lane); return; }
    it -= T_OUT;
    { const int mi = it >> 3, sub = it & 7, g = mi >> 4, d = (mi >> 3) & 1, n = mi & 7;
      transpose_item(a.in[g ? 16 : 14] + (size_t)(d * 8 + n) * 16384, 128, 128, (bf16_t*)(ws + WS_WG) + (size_t)((n * 2 + d) * 2 + g) * 16384, 64 * (sub >> 2), 32 * (sub & 3), 32 * (sub & 3), scr, lane); }
}
__device__ __forceinline__ void phase0(const Args& a, unsigned char* lds, int tid, int lane, int wave) {
    const int G = gridDim.x, bx = blockIdx.x;
    float* sc = (float*)lds;
    float* red = (float*)(lds + 24576);
    float* mod = (float*)(a.ws + WS_MOD);
    if (bx < 144) {
        for (int i = tid; i < 3 * D; i += NTHR) { const int r = i >> 11, k = i & 2047; const float c = r < 2 ? a.in[1][r * D + k] : a.in[3][k]; sc[i] = siluf_(c); }
        __syncthreads();
        for (int it = bx; it < 144; it += G) {
            const float* w = a.in[4] + (size_t)(wave * 256) * NMOD + it * 128 + 2 * lane;
            float a00 = 0.f, a01 = 0.f, a10 = 0.f, a11 = 0.f, a20 = 0.f, a21 = 0.f;
#pragma unroll 8
            for (int k = 0; k < 256; ++k) {
                const float2 wv = *(const float2*)(w + (size_t)k * NMOD);
                const float s0 = sc[wave * 256 + k], s1 = sc[D + wave * 256 + k], s2 = sc[2 * D + wave * 256 + k];
                a00 += s0 * wv.x; a01 += s0 * wv.y; a10 += s1 * wv.x; a11 += s1 * wv.y; a20 += s2 * wv.x; a21 += s2 * wv.y;
            }
            red[(wave * 6 + 0) * 64 + lane] = a00; red[(wave * 6 + 1) * 64 + lane] = a01; red[(wave * 6 + 2) * 64 + lane] = a10;
            red[(wave * 6 + 3) * 64 + lane] = a11; red[(wave * 6 + 4) * 64 + lane] = a20; red[(wave * 6 + 5) * 64 + lane] = a21;
            __syncthreads();
            if (tid < 384) { const int r = tid >> 7, cc = tid & 127; float s = a.in[5][it * 128 + cc];
#pragma unroll
                for (int w8 = 0; w8 < 8; ++w8) s += red[(w8 * 6 + r * 2 + (cc & 1)) * 64 + (cc >> 1)];
                mod[(size_t)r * NMOD + it * 128 + cc] = s; }
            __syncthreads();
        }
    }
    __syncthreads();
    { u32x4* z = (u32x4*)((bf16_t*)(a.ws + WS_WIN) + (size_t)DIN * D); const int nz = (DINP - DIN) * D / 8;
      for (int i = bx * NTHR + tid; i < nz; i += G * NTHR) z[i] = (u32x4){0u, 0u, 0u, 0u}; }
    float* scr = (float*)(lds + wave * 16384);
    if (G == 256) {
        const int start = bx < 144 ? 106 * bx : 144 * 106 + 232 * (bx - 144), cnt = bx < 144 ? 106 : 232;
        for (int i = wave; i < cnt; i += 8) p0_item(a, start + i, scr, lane);
    } else {
        for (int it = bx * 8 + wave; it < T_ALL; it += G * 8) p0_item(a, it, scr, lane);
    }
}
static_assert(144 * 106 + 112 * 232 == T_ALL, "phase-0 split");

__device__ __forceinline__ void norm_mod_rows(const float* srcL, const float* srcC, int nrows, const float* gnorm, const float* mod, int sub, bf16_t* XN, int gw, int NGW, int lane) {
    for (int m = gw; m < nrows; m += NGW) {
        const float* xr = m < ML ? srcL + (size_t)m * D : srcC + (size_t)(m - ML) * D;
        const int mr = m < ML ? (m >> 12) : 2;
        const float* sh = mod + (size_t)mr * NMOD + (3 * sub) * D; const float* scl = sh + D;
        f32x4 v[8]; float s = 0.f;
#pragma unroll
        for (int j = 0; j < 8; ++j) { v[j] = ((const f32x4*)xr)[lane + 64 * j]; s += (v[j].x * v[j].x + v[j].y * v[j].y) + (v[j].z * v[j].z + v[j].w * v[j].w); }
        const float r = 1.0f / sqrtf(wave_sum(s) * (1.0f / D) + EPS);
        unsigned long long* o8 = (unsigned long long*)(XN + (size_t)m * D) + lane;
#pragma unroll
        for (int j = 0; j < 8; ++j) {
            const f32x4 g = ((const f32x4*)gnorm)[lane + 64 * j], shv = ((const f32x4*)sh)[lane + 64 * j], scv = ((const f32x4*)scl)[lane + 64 * j];
            const f32x4 y = (v[j] * r * g) * (scv + 1.0f) + shv;
            o8[64 * j] = (unsigned long long)pk2(y.x, y.y) | ((unsigned long long)pk2(y.z, y.w) << 32);
        }
    }
}
__device__ __forceinline__ void final_norm_rows(const float* X, const float* gnorm, float* out, int gw, int NGW, int lane) {
    for (int m = gw; m < ML; m += NGW) {
        const f32x4* xr = (const f32x4*)(X + (size_t)m * D) + lane;
        f32x4 v[8]; float s = 0.f;
#pragma unroll
        for (int j = 0; j < 8; ++j) { v[j] = xr[64 * j]; s += (v[j].x * v[j].x + v[j].y * v[j].y) + (v[j].z * v[j].z + v[j].w * v[j].w); }
        const float r = 1.0f / sqrtf(wave_sum(s) * (1.0f / D) + EPS);
        f32x4* o = (f32x4*)(out + (size_t)m * D) + lane;
#pragma unroll
        for (int j = 0; j < 8; ++j) { const f32x4 g = ((const f32x4*)gnorm)[lane + 64 * j]; o[64 * j] = v[j] * r * g; }
    }
}

__device__ __forceinline__ void lru_local_item(unsigned char* lds, int item, const Args& a, int tid, int lane, int wave) {
    const bf16_t* P = (const bf16_t*)(a.ws + WS_ACT);
    const bf16_t* WG = (const bf16_t*)(a.ws + WS_WG);
    bf16_t* HL = (bf16_t*)(a.ws + WS_HL); bf16_t* AC = (bf16_t*)(a.ws + WS_AC);
    float* CSUM = (float*)(a.ws + WS_CSUM);
    float* XC = (float*)lds;
    float* LA = (float*)(lds + 33792);
    float* LB = (float*)(lds + 67584);
    float* SEG = (float*)(lds + 101376);
    const int n = item & 7, sc = item >> 3;
    int b, ck, rowbase, seqlen, chunkidx; bool islat;
    if (sc < 128) { b = sc >> 6; ck = sc & 63; rowbase = b * SEQ; seqlen = SEQ; islat = true; chunkidx = 4 + ck; }
    else { const int s2 = sc - 128; b = s2 >> 2; ck = s2 & 3; rowbase = ML + b * CTXL; seqlen = CTXL; islat = false; chunkidx = ck; }
    const int t0 = ck * 64;
    {
        const int tok = tid >> 3, c8 = tid & 7, ch0 = n * 128 + c8 * 16;
        float accv[16];
#pragma unroll
        for (int i = 0; i < 16; i += 4) { const f32x4 bb = *(const f32x4*)(a.in[13] + ch0 + i); accv[i] = bb.x; accv[i + 1] = bb.y; accv[i + 2] = bb.z; accv[i + 3] = bb.w; }
#pragma unroll
        for (int k = 0; k < 4; ++k) {
            const int t = t0 + tok + k - 2;
            if (t >= 0 && t < seqlen) {
                const u32x4* src = (const u32x4*)(P + (size_t)(rowbase + t) * DINP + PC_LX + ch0);
                const u32x4 x0 = src[0], x1 = src[1];
                const float* cw = a.in[12] + k * 1024 + ch0;
                const unsigned xw[8] = {x0.x, x0.y, x0.z, x0.w, x1.x, x1.y, x1.z, x1.w};
#pragma unroll
                for (int i = 0; i < 8; ++i) { accv[2 * i] += cw[2 * i] * bflo(xw[i]); accv[2 * i + 1] += cw[2 * i + 1] * bfhi(xw[i]); }
            }
        }
#pragma unroll
        for (int i = 0; i < 16; i += 4) *(f32x4*)(XC + tok * 132 + c8 * 16 + i) = (f32x4){accv[i], accv[i + 1], accv[i + 2], accv[i + 3]};
    }
    __syncthreads();
    const int fr = lane & 15, fq = lane >> 4;
#pragma unroll 1
    for (int d = 0; d < 2; ++d) {
        {
            const int col = 16 * wave + fr, ch = n * 128 + col;
            const bf16_t* wg = WG + (size_t)((n * 2 + d) * 2) * 16384 + (size_t)col * 128 + fq * 8;
            bf16x8 Br[4], Bi[4];
#pragma unroll
            for (int ks = 0; ks < 4; ++ks) { Br[ks] = *(const bf16x8*)(wg + ks * 32); Bi[ks] = *(const bf16x8*)(wg + 16384 + ks * 32); }
            const float brv = a.in[15][d * 1024 + ch], biv = a.in[17][d * 1024 + ch];
            const float sp = log1pf(__expf(-a.in[18][d * 1024 + ch]));
#pragma unroll
            for (int m = 0; m < 4; ++m) {
                f32x4 ar = {0.f, 0.f, 0.f, 0.f}, ai = {0.f, 0.f, 0.f, 0.f};
#pragma unroll
                for (int ks = 0; ks < 4; ++ks) { const bf16x8 A = pack8(XC + (16 * m + fr) * 132 + ks * 32 + fq * 8); ar = MFMA16(A, Br[ks], ar); ai = MFMA16(A, Bi[ks], ai); }
#pragma unroll
                for (int j = 0; j < 4; ++j) {
                    const int tok = 16 * m + 4 * fq + j;
                    const float r = sigmoidf_(ar[j] + brv), ii = sigmoidf_(ai[j] + biv);
                    const float la = -8.0f * r * sp, av = __expf(la), mult = sqrtf(fmaxf(-expm1f(2.0f * la), 0.f));
                    LA[tok * 132 + col] = av; LB[tok * 132 + col] = mult * ii * XC[tok * 132 + col];
                }
            }
        }
        __syncthreads();
        {
            const int seg = tid >> 7, ch = tid & 127;
            float hl[16], Al[16]; float h = 0.f, A = 1.f;
#pragma unroll
            for (int qi = 0; qi < 16; ++qi) { const int q = seg * 16 + qi, tok = d ? 63 - q : q; const float av = LA[tok * 132 + ch], bx = LB[tok * 132 + ch]; h = av * h + bx; A *= av; hl[qi] = h; Al[qi] = A; }
            SEG[(seg * 128 + ch) * 2] = A; SEG[(seg * 128 + ch) * 2 + 1] = h;
            __syncthreads();
            float carry = 0.f, Ap = 1.f;
#pragma unroll
            for (int s = 0; s < 3; ++s) if (s < seg) { const float As = SEG[(s * 128 + ch) * 2], hs = SEG[(s * 128 + ch) * 2 + 1]; carry = As * carry + hs; Ap *= As; }
            float Hlast = 0.f, Alast = 0.f;
#pragma unroll
            for (int qi = 0; qi < 16; ++qi) {
                const int q = seg * 16 + qi, tok = d ? 63 - q : q;
                const float H = hl[qi] + Al[qi] * carry, Ac = Al[qi] * Ap; Hlast = H; Alast = Ac;
                if (islat) { const size_t o = ((size_t)d * ML + rowbase + t0 + tok) * 1024 + n * 128 + ch; HL[o] = f2bf(H); AC[o] = f2bf(Ac); }
            }
            if (seg == 3) { const size_t o = ((size_t)((d * 2 + b) * 68 + chunkidx) * 2) * 1024 + n * 128 + ch; CSUM[o] = Alast; CSUM[o + 1024] = Hlast; }
        }
        __syncthreads();
    }
}

__device__ __forceinline__ void lru_carry(const Args& a, int gtid, int nthr) {
    const float* __restrict__ CSUM = (const float*)(a.ws + WS_CSUM);
    float* __restrict__ CARRY = (float*)(a.ws + WS_CARRY);
    for (int idx = gtid; idx < 4096; idx += nthr) {
        const int ch = idx & 1023, b = (idx >> 10) & 1, d = idx >> 11;
        const float* base = CSUM + (size_t)((d * 2 + b) * 68) * 2 * 1024 + ch;
        float carry = 0.f;
#pragma unroll 1
        for (int half = 0; half < 2; ++half) {
            float Av[34], hv[34];
#pragma unroll
            for (int s = 0; s < 34; ++s) { const int st = half * 34 + s; const int chunk = d == 0 ? st : (st < 4 ? 3 - st : 71 - st);
                Av[s] = base[(size_t)(chunk * 2) * 1024]; hv[s] = base[(size_t)(chunk * 2 + 1) * 1024]; }
#pragma unroll
            for (int s = 0; s < 34; ++s) { const int st = half * 34 + s; const int chunk = d == 0 ? st : (st < 4 ? 3 - st : 71 - st);
                if (chunk >= 4) CARRY[(size_t)((d * 2 + b) * 64 + (chunk - 4)) * 1024 + ch] = carry;
                carry = Av[s] * carry + hv[s]; }
        }
    }
}

__device__ __forceinline__ void lru_combine_rows(const Args& a, int gw, int NGW, int lane) {
    const bf16_t* P = (const bf16_t*)(a.ws + WS_ACT);
    const bf16_t* HL = (const bf16_t*)(a.ws + WS_HL); const bf16_t* AC = (const bf16_t*)(a.ws + WS_AC);
    const float* CARRY = (const float*)(a.ws + WS_CARRY);
    bf16_t* YA = (bf16_t*)(a.ws + WS_YA);
    for (int r = gw; r < ML; r += NGW) {
        const int b = r >> 12, ck = (r & 4095) >> 6;
#pragma unroll
        for (int jj = 0; jj < 2; ++jj) {
            const int ch = 8 * lane + 512 * jj;
            const u32x4 hf = *(const u32x4*)(HL + (size_t)r * 1024 + ch), af = *(const u32x4*)(AC + (size_t)r * 1024 + ch);
            const u32x4 hb = *(const u32x4*)(HL + ((size_t)ML + r) * 1024 + ch), ab = *(const u32x4*)(AC + ((size_t)ML + r) * 1024 + ch);
            const u32x4 lg = *(const u32x4*)(P + (size_t)r * DINP + PC_LG + ch);
            const float* cfp = CARRY + (size_t)((0 * 2 + b) * 64 + ck) * 1024 + ch; const float* cbp = CARRY + (size_t)((1 * 2 + b) * 64 + ck) * 1024 + ch;
            const f32x4 cf0 = *(const f32x4*)cfp, cf1 = *(const f32x4*)(cfp + 4), cb0 = *(const f32x4*)cbp, cb1 = *(const f32x4*)(cbp + 4);
            const float cf[8] = {cf0.x, cf0.y, cf0.z, cf0.w, cf1.x, cf1.y, cf1.z, cf1.w}, cb[8] = {cb0.x, cb0.y, cb0.z, cb0.w, cb1.x, cb1.y, cb1.z, cb1.w};
            const unsigned hfw[4] = {hf.x, hf.y, hf.z, hf.w}, afw[4] = {af.x, af.y, af.z, af.w}, hbw[4] = {hb.x, hb.y, hb.z, hb.w}, abw[4] = {ab.x, ab.y, ab.z, ab.w}, lgw[4] = {lg.x, lg.y, lg.z, lg.w};
            unsigned ow[4];
#pragma unroll
            for (int i = 0; i < 4; ++i) {
                const float r0 = bflo(hfw[i]) + bflo(afw[i]) * cf[2 * i] + bflo(hbw[i]) + bflo(abw[i]) * cb[2 * i];
                const float r1 = bfhi(hfw[i]) + bfhi(afw[i]) * cf[2 * i + 1] + bfhi(hbw[i]) + bfhi(abw[i]) * cb[2 * i + 1];
                ow[i] = pk2(gelu_tanhf_(bflo(lgw[i])) * r0, gelu_tanhf_(bfhi(lgw[i])) * r1);
            }
            *(u32x4*)(YA + (size_t)r * D + ch) = (u32x4){ow[0], ow[1], ow[2], ow[3]};
        }
    }
}

__device__ __forceinline__ int mrow_lat(int b, int p) { return b * SEQ + ((p & 63) << 6) + (p >> 6); }

__device__ __forceinline__ void mlstm_local_item(unsigned char* lds, int item, const Args& a, int tid, int lane, int wave) {
    const bf16_t* P = (const bf16_t*)(a.ws + WS_ACT);
    const float* Gt = (const float*)(a.ws + WS_G);
    float* CST = (float*)(a.ws + WS_CST); float* MSC = (float*)(a.ws + WS_MSC);
    bf16_t* VT = (bf16_t*)lds;
    bf16_t* KW = (bf16_t*)(lds + 34816);
    float* WGs = (float*)(lds + 69632);
    const int cidx = item % 34, bh = item / 34, h = bh & 7, b = bh >> 3;
    const int chain0 = (b * 8 + h) * 2;
#define MROW(j) (cidx < 2 ? ML + b * CTXL + cidx * 128 + (j) : mrow_lat(b, (cidx - 2) * 128 + (j)))
    if (wave < 2) {
        const int d = wave;
        const int j0 = d ? 127 - 2 * lane : 2 * lane, j1 = d ? 126 - 2 * lane : 2 * lane + 1;
        const float* g0p = Gt + (size_t)MROW(j0) * 32 + h; const float* g1p = Gt + (size_t)MROW(j1) * 32 + h;
        const float ig0 = g0p[(2 * d) * 8], fg0 = g0p[(2 * d + 1) * 8], ig1 = g1p[(2 * d) * 8], fg1 = g1p[(2 * d + 1) * 8];
        const float l0 = logsigmoidf_(fg0), l1 = logsigmoidf_(fg1);
        const float s1 = l0 + l1, incl = wave_incl_sum(s1, lane), excl = incl - s1, bc0 = excl + l0, bc1 = excl + s1;
        const float blast = __shfl(incl, 63);
        const float gg0 = blast - bc0 + ig0, gg1 = blast - bc1 + ig1;
        const float mloc = wave_max(fmaxf(gg0, gg1));
        WGs[d * 128 + j0] = __expf(gg0 - mloc); WGs[d * 128 + j1] = __expf(gg1 - mloc);
        if (lane == 0) { MSC[(size_t)((chain0 + d) * 34 + cidx) * 2] = mloc; MSC[(size_t)((chain0 + d) * 34 + cidx) * 2 + 1] = blast; }
    }
    const int j = tid >> 2, q4 = tid & 3; const size_t prow = (size_t)MROW(j) * DINP;
    {
        const u32x4* vs = (const u32x4*)(P + prow + PC_V + h * 128 + q4 * 32);
#pragma unroll
        for (int c = 0; c < 4; ++c) { const u32x4 x = vs[c]; const unsigned xw[4] = {x.x, x.y, x.z, x.w};
#pragma unroll
            for (int i = 0; i < 4; ++i) { VT[(q4 * 32 + c * 8 + 2 * i) * 136 + j] = (bf16_t)(xw[i] & 0xffffu); VT[(q4 * 32 + c * 8 + 2 * i + 1) * 136 + j] = (bf16_t)(xw[i] >> 16); } }
    }
    const u32x4* ks_ = (const u32x4*)(P + prow + PC_K + h * 64 + q4 * 16);
    const u32x4 k0 = ks_[0], k1 = ks_[1];
    __syncthreads();
    {
        const unsigned kw[8] = {k0.x, k0.y, k0.z, k0.w, k1.x, k1.y, k1.z, k1.w};
#pragma unroll
        for (int d = 0; d < 2; ++d) { const float w = WGs[d * 128 + j] * 0.125f;
#pragma unroll
            for (int i = 0; i < 8; ++i) { KW[(d * 64 + q4 * 16 + 2 * i) * 136 + j] = f2bf(bflo(kw[i]) * w); KW[(d * 64 + q4 * 16 + 2 * i + 1) * 136 + j] = f2bf(bfhi(kw[i]) * w); } }
    }
    __syncthreads();
    const int fr = lane & 15, fq = lane >> 4;
#pragma unroll
    for (int d = 0; d < 2; ++d) {
        f32x4 acc[4];
#pragma unroll
        for (int nt = 0; nt < 4; ++nt) acc[nt] = (f32x4){0.f, 0.f, 0.f, 0.f};
#pragma unroll
        for (int ks = 0; ks < 4; ++ks) {
            const bf16x8 A = *(const bf16x8*)(VT + (16 * wave + fr) * 136 + ks * 32 + fq * 8);
#pragma unroll
            for (int nt = 0; nt < 4; ++nt) { const bf16x8 B = *(const bf16x8*)(KW + (d * 64 + 16 * nt + fr) * 136 + ks * 32 + fq * 8); acc[nt] = MFMA16(A, B, acc[nt]); }
        }
        float* dst = CST + (size_t)((chain0 + d) * 34 + cidx) * CSTE;
#pragma unroll
        for (int nt = 0; nt < 4; ++nt)
#pragma unroll
            for (int i = 0; i < 4; ++i) dst[(16 * wave + 4 * fq + i) * 64 + 16 * nt + fr] = acc[nt][i];
    }
    if (tid < 128) { const int d = tid >> 6, k = tid & 63; float s = 0.f;
        for (int jj = 0; jj < 128; jj += 2) { const unsigned w = *(const unsigned*)(KW + (d * 64 + k) * 136 + jj); s += bflo(w) + bfhi(w); }
        CST[(size_t)((chain0 + d) * 34 + cidx) * CSTE + 8192 + k] = s; }
    __syncthreads();
#undef MROW
}

__device__ __forceinline__ void mlstm_state_scan(const Args& a, int gtid, int nthr) {
    const float* __restrict__ CST = (const float*)(a.ws + WS_CST);
    const float* __restrict__ MSC = (const float*)(a.ws + WS_MSC);
    float* __restrict__ CPREV = (float*)(a.ws + WS_CPREV);
    float* __restrict__ MPREV = (float*)(a.ws + WS_MSC + 65536);
    for (int idx = gtid; idx < 32 * CSTE; idx += nthr) {
        const int chain = idx / CSTE, e = idx - chain * CSTE, d = chain & 1;
        float tv[34];
#pragma unroll
        for (int s = 0; s < 34; ++s) { const int cidx = d == 0 ? s : (s < 2 ? 1 - s : 35 - s); tv[s] = CST[(size_t)(chain * 34 + cidx) * CSTE + e]; }
        float val = 0.f, m = 0.f;
#pragma unroll
        for (int s = 0; s < 34; ++s) {
            const int cidx = d == 0 ? s : (s < 2 ? 1 - s : 35 - s);
            const float mloc = MSC[(size_t)(chain * 34 + cidx) * 2], bl = MSC[(size_t)(chain * 34 + cidx) * 2 + 1];
            if (cidx >= 2) { CPREV[(size_t)(chain * 32 + cidx - 2) * CSTE + e] = val; if (e == 0) MPREV[chain * 32 + cidx - 2] = m; }
            const float mn = fmaxf(bl + m, mloc);
            val = __expf(bl + m - mn) * val + __expf(mloc - mn) * tv[s]; m = mn;
        }
    }
}

__device__ __forceinline__ void mlstm_out_item(unsigned char* lds, int item, const Args& a, int tid, int lane, int wave) {
    const bf16_t* P = (const bf16_t*)(a.ws + WS_ACT);
    const float* Gt = (const float*)(a.ws + WS_G);
    const float* CPREV = (const float*)(a.ws + WS_CPREV); const float* MPREV = (const float*)(a.ws + WS_MSC + 65536);
    bf16_t* YA = (bf16_t*)(a.ws + WS_YA);
    bf16_t* Qs = (bf16_t*)lds;
    bf16_t* Ks = (bf16_t*)(lds + 18432);
    bf16_t* VT = (bf16_t*)(lds + 36864);
    bf16_t* Ws = (bf16_t*)(lds + 71680);
    bf16_t* Cs = (bf16_t*)(lds + 106496);
    float* BC = (float*)(lds + 127232);
    float* UU = (float*)(lds + 127232 + 1024);
    float* MM = (float*)(lds + 127232 + 2048);
    float* MP = (float*)(lds + 127232 + 3072);
    const int c = item & 31, bh = item >> 5, h = bh & 7, b = bh >> 3;
    const int chain0 = (b * 8 + h) * 2;
    if (wave < 2) {
        const int d = wave; const float mprev = MPREV[(chain0 + d) * 32 + c];
        const int j0 = d ? 127 - 2 * lane : 2 * lane, j1 = d ? 126 - 2 * lane : 2 * lane + 1;
        const float* g0p = Gt + (size_t)mrow_lat(b, c * 128 + j0) * 32 + h; const float* g1p = Gt + (size_t)mrow_lat(b, c * 128 + j1) * 32 + h;
        const float ig0 = g0p[(2 * d) * 8], fg0 = g0p[(2 * d + 1) * 8], ig1 = g1p[(2 * d) * 8], fg1 = g1p[(2 * d + 1) * 8];
        const float l0 = logsigmoidf_(fg0), l1 = logsigmoidf_(fg1);
        const float s1 = l0 + l1, incl = wave_incl_sum(s1, lane), excl = incl - s1, bc0 = excl + l0, bc1 = excl + s1;
        const float u0 = ig0 - bc0, u1 = ig1 - bc1;
        const float p1 = fmaxf(u0, u1), inclm = wave_incl_max(p1, lane);
        float exclm = __shfl_up(inclm, 1); if (lane == 0) exclm = -INFINITY;
        BC[d * 128 + j0] = bc0; BC[d * 128 + j1] = bc1; UU[d * 128 + j0] = u0; UU[d * 128 + j1] = u1;
        MM[d * 128 + j0] = fmaxf(mprev, fmaxf(exclm, u0)); MM[d * 128 + j1] = fmaxf(mprev, fmaxf(exclm, p1));
        if (lane == 0) MP[d] = mprev;
    }
    {
        const int j = tid >> 2, q4 = tid & 3; const size_t prow = (size_t)mrow_lat(b, c * 128 + j) * DINP;
        const u32x4* qs_ = (const u32x4*)(P + prow + PC_Q + h * 64 + q4 * 16);
        *(u32x4*)(Qs + j * 72 + q4 * 16) = qs_[0]; *(u32x4*)(Qs + j * 72 + q4 * 16 + 8) = qs_[1];
        const u32x4* ks_ = (const u32x4*)(P + prow + PC_K + h * 64 + q4 * 16);
#pragma unroll
        for (int cc = 0; cc < 2; ++cc) { const u32x4 x = ks_[cc]; u32x4 y;
            y.x = pk2(bflo(x.x) * 0.125f, bfhi(x.x) * 0.125f); y.y = pk2(bflo(x.y) * 0.125f, bfhi(x.y) * 0.125f); y.z = pk2(bflo(x.z) * 0.125f, bfhi(x.z) * 0.125f); y.w = pk2(bflo(x.w) * 0.125f, bfhi(x.w) * 0.125f);
            *(u32x4*)(Ks + j * 72 + q4 * 16 + cc * 8) = y; }
        const u32x4* vs = (const u32x4*)(P + prow + PC_V + h * 128 + q4 * 32);
#pragma unroll
        for (int cc = 0; cc < 4; ++cc) { const u32x4 x = vs[cc]; const unsigned xw[4] = {x.x, x.y, x.z, x.w};
#pragma unroll
            for (int i = 0; i < 4; ++i) { VT[(q4 * 32 + cc * 8 + 2 * i) * 136 + j] = (bf16_t)(xw[i] & 0xffffu); VT[(q4 * 32 + cc * 8 + 2 * i + 1) * 136 + j] = (bf16_t)(xw[i] >> 16); } }
    }
    for (int i = tid; i < 540; i += NTHR) ((unsigned*)(Cs + 129 * 72))[i] = 0u;
    __syncthreads();
    const int fr = lane & 15, fq = lane >> 4, trow = 16 * wave + 4 * fq;
    f32x4 S[8];
#pragma unroll
    for (int nt = 0; nt < 8; ++nt) S[nt] = (f32x4){0.f, 0.f, 0.f, 0.f};
#pragma unroll
    for (int ks = 0; ks < 2; ++ks) {
        const bf16x8 A = *(const bf16x8*)(Qs + (16 * wave + fr) * 72 + ks * 32 + fq * 8);
#pragma unroll
        for (int nt = 0; nt < 8; ++nt) { const bf16x8 B = *(const bf16x8*)(Ks + (16 * nt + fr) * 72 + ks * 32 + fq * 8); S[nt] = MFMA16(A, B, S[nt]); }
    }
    f32x4 hsum[8];
#pragma unroll
    for (int nt = 0; nt < 8; ++nt) hsum[nt] = (f32x4){0.f, 0.f, 0.f, 0.f};
#pragma unroll 1
    for (int d = 0; d < 2; ++d) {
        { const f32x4* src = (const f32x4*)(CPREV + (size_t)((chain0 + d) * 32 + c) * CSTE);
          for (int i = tid; i < CSTE / 4; i += NTHR) { const f32x4 x = src[i]; const int e = i * 4, v = e >> 6, k = e & 63;
              *(unsigned long long*)(Cs + v * 72 + k) = (unsigned long long)pk2(x.x, x.y) | ((unsigned long long)pk2(x.z, x.w) << 32); } }
        float Mt[4], den2[4];
#pragma unroll
        for (int i = 0; i < 4; ++i) { Mt[i] = MM[d * 128 + trow + i]; den2[i] = 0.f; }
#pragma unroll
        for (int nt = 0; nt < 8; ++nt) {
            const int s = 16 * nt + fr; const float us = UU[d * 128 + s];
#pragma unroll
            for (int i = 0; i < 4; ++i) { const int t = trow + i; const bool ok = d ? (s >= t) : (s <= t);
                const float wv = ok ? S[nt][i] * __expf(us - Mt[i]) : 0.f; den2[i] += wv; Ws[t * 136 + s] = f2bf(wv); }
        }
#pragma unroll
        for (int i = 0; i < 4; ++i) { float v = den2[i]; v += __shfl_xor(v, 1); v += __shfl_xor(v, 2); v += __shfl_xor(v, 4); v += __shfl_xor(v, 8); den2[i] = v; }
        __syncthreads();
        f32x4 O[9];
#pragma unroll
        for (int nt = 0; nt < 9; ++nt) O[nt] = (f32x4){0.f, 0.f, 0.f, 0.f};
#pragma unroll
        for (int ks = 0; ks < 2; ++ks) {
            const bf16x8 A = *(const bf16x8*)(Qs + (16 * wave + fr) * 72 + ks * 32 + fq * 8);
#pragma unroll
            for (int nt = 0; nt < 9; ++nt) { const bf16x8 B = *(const bf16x8*)(Cs + (16 * nt + fr) * 72 + ks * 32 + fq * 8); O[nt] = MFMA16(A, B, O[nt]); }
        }
        const float mprev = MP[d];
        float si[4], den1[4];
#pragma unroll
        for (int i = 0; i < 4; ++i) { si[i] = __expf(mprev - Mt[i]); den1[i] = __shfl(O[8][i], lane & 48); }
#pragma unroll
        for (int nt = 0; nt < 8; ++nt)
#pragma unroll
            for (int i = 0; i < 4; ++i) O[nt][i] *= si[i];
#pragma unroll
        for (int ks = 0; ks < 4; ++ks) {
            const bf16x8 A = *(const bf16x8*)(Ws + (16 * wave + fr) * 136 + ks * 32 + fq * 8);
#pragma unroll
            for (int nt = 0; nt < 8; ++nt) { const bf16x8 B = *(const bf16x8*)(VT + (16 * nt + fr) * 136 + ks * 32 + fq * 8); O[nt] = MFMA16(A, B, O[nt]); }
        }
#pragma unroll
        for (int i = 0; i < 4; ++i) {
            const float den = si[i] * den1[i] + den2[i];
            const float dn = fmaxf(fabsf(den), __expf(-(BC[d * 128 + trow + i] + Mt[i])));
            const float inv = 1.0f / dn;
#pragma unroll
            for (int nt = 0; nt < 8; ++nt) hsum[nt][i] += O[nt][i] * inv;
        }
        __syncthreads();
    }
    const float* gain = a.in[19] + h * 128;
#pragma unroll
    for (int i = 0; i < 4; ++i) {
        float ss = 0.f;
#pragma unroll
        for (int nt = 0; nt < 8; ++nt) ss += hsum[nt][i] * hsum[nt][i];
        ss += __shfl_xor(ss, 1); ss += __shfl_xor(ss, 2); ss += __shfl_xor(ss, 4); ss += __shfl_xor(ss, 8);
        const float rinv = 1.0f / sqrtf(ss * (1.0f / 128.0f) + EPS);
        const size_t row = (size_t)mrow_lat(b, c * 128 + trow + i);
#pragma unroll
        for (int nt = 0; nt < 8; ++nt) { const int v = 16 * nt + fr;
            const float o = bf2f(P[row * DINP + PC_O + h * 128 + v]);
            YA[row * D + 1024 + h * 128 + v] = f2bf(hsum[nt][i] * rinv * gain[v] * sigmoidf_(o)); }
    }
    __syncthreads();
}

#ifndef PROBE
#define PROBE 0
#endif
#ifndef STAGE
#define STAGE 99
#endif
__global__ void __launch_bounds__(NTHR, 2) mega(Args a) {
    extern __shared__ __attribute__((aligned(16))) unsigned char lds[];
    cg::grid_group grid = cg::this_grid();
    const int tid = threadIdx.x, lane = tid & 63, wave = __builtin_amdgcn_readfirstlane(tid >> 6);
    const int G = gridDim.x, gw = blockIdx.x * 8 + wave, NGW = G * 8;
    unsigned char* ws = a.ws;
    float* mod = (float*)(ws + WS_MOD);
    bf16_t* XN = (bf16_t*)(ws + WS_XN);
    bf16_t* ACT = (bf16_t*)(ws + WS_ACT);
    bf16_t* P = (bf16_t*)(ws + WS_ACT);
    float* X = (float*)(ws + WS_X);
    PG8_LAS unsigned char* ldsl = (PG8_LAS unsigned char*)lds;
    volatile LAS unsigned* MISC = (volatile LAS unsigned*)(ldsl + (LDS_BYTES - 64));
    if (tid < 16) MISC[tid] = 0u;
    __syncthreads();
    const XcdBarrier xbar = xcd_barrier_post((unsigned*)(ws + WS_BAR), MISC + 8);
    if (a.never) grid.sync();
#define GSYNC() xcd_barrier(xbar)

    phase0(a, lds, tid, lane, wave);
    GSYNC();
#if PROBE == 6
    for (int i = 0; i < 10; ++i) GSYNC();
#endif
#if PROBE == 1
    phase0(a, lds, tid, lane, wave);
    GSYNC();
#endif
    norm_mod_rows(a.in[0], a.in[2], MT, a.in[6], mod, 0, XN, gw, NGW, lane);
    GSYNC();
    { pg8::Gemm g{XN, (const bf16_t*)(ws + WS_WUP1), MT, 2 * DFF, D}; pg8::StaticOrder S; S.init(MT, 2 * DFF, G, (int)blockIdx.x);
      EpiSwiglu E{ACT, DFF}; pg8::gemm_phase<EpiSwiglu, pg8::StaticOrder, true, true>(ldsl, g, S, E); }
    GSYNC();
#if PROBE == 2
    { pg8::Gemm g{XN, (const bf16_t*)(ws + WS_WUP1), MT, 2 * DFF, D}; pg8::StaticOrder S; S.init(MT, 2 * DFF, G, (int)blockIdx.x);
      EpiSwiglu E{ACT, DFF}; pg8::gemm_phase<EpiSwiglu, pg8::StaticOrder, true, true>(ldsl, g, S, E); }
    GSYNC();
#endif
    { pg8::Gemm g{ACT, (const bf16_t*)(ws + WS_WDN1), MT, D, DFF}; pg8::StaticOrder S; S.init(MT, D, G, (int)blockIdx.x);
      EpiResid E{a.in[0], a.in[2], X, mod, 2 * D, 0.5f}; pg8::gemm_phase<EpiResid, pg8::StaticOrder, true, true>(ldsl, g, S, E); }
    GSYNC();
#if STAGE >= 2
    norm_mod_rows(X, X + (size_t)ML * D, MT, a.in[9], mod, 1, XN, gw, NGW, lane);
    GSYNC();
    { pg8::Gemm g{XN, (const bf16_t*)(ws + WS_WIN), MT, DINP, D}; pg8::StaticOrder S; S.init(MT, DINP, G, (int)blockIdx.x);
      EpiInProj E{P, (float*)(ws + WS_G), a.in[11]}; pg8::gemm_phase<EpiInProj, pg8::StaticOrder, true, true>(ldsl, g, S, E); }
    GSYNC();
    for (int it = blockIdx.x; it < 1088 + 544; it += G) {
        if (it < 1088) lru_local_item(lds, it, a, tid, lane, wave);
        else mlstm_local_item(lds, it - 1088, a, tid, lane, wave);
    }
    GSYNC();
    lru_carry(a, blockIdx.x * NTHR + tid, G * NTHR);
    mlstm_state_scan(a, blockIdx.x * NTHR + tid, G * NTHR);
    GSYNC();
    for (int it = blockIdx.x; it < 512; it += G) mlstm_out_item(lds, it, a, tid, lane, wave);
    lru_combine_rows(a, gw, NGW, lane);
    GSYNC();
#if PROBE == 3
    for (int it = blockIdx.x; it < 1088 + 544; it += G) {
        if (it < 1088) lru_local_item(lds, it, a, tid, lane, wave);
        else mlstm_local_item(lds, it - 1088, a, tid, lane, wave);
    }
    GSYNC();
#endif
#if PROBE == 4
    lru_carry(a, blockIdx.x * NTHR + tid, G * NTHR);
    mlstm_state_scan(a, blockIdx.x * NTHR + tid, G * NTHR);
    GSYNC();
#endif
#if PROBE == 5
    for (int it = blockIdx.x; it < 512; it += G) mlstm_out_item(lds, it, a, tid, lane, wave);
    lru_combine_rows(a, gw, NGW, lane);
    GSYNC();
#endif
    { pg8::Gemm g{(const bf16_t*)(ws + WS_YA), (const bf16_t*)(ws + WS_WOUT), ML, D, D}; pg8::StaticOrder S; S.init(ML, D, G, (int)blockIdx.x);
      EpiResid E{X, X, X, mod, 5 * D, 1.0f}; pg8::gemm_phase<EpiResid, pg8::StaticOrder, true, true>(ldsl, g, S, E); }
    GSYNC();
#endif
#if STAGE >= 3
    norm_mod_rows(X, X, ML, a.in[21], mod, 2, XN, gw, NGW, lane);
    GSYNC();
    { pg8::Gemm g{XN, (const bf16_t*)(ws + WS_WUP2), ML, 2 * DFF, D}; pg8::StaticOrder S; S.init(ML, 2 * DFF, G, (int)blockIdx.x);
      EpiSwiglu E{ACT, DFF}; pg8::gemm_phase<EpiSwiglu, pg8::StaticOrder, true, true>(ldsl, g, S, E); }
    GSYNC();
    { pg8::Gemm g{ACT, (const bf16_t*)(ws + WS_WDN2), ML, D, DFF}; pg8::StaticOrder S; S.init(ML, D, G, (int)blockIdx.x);
      EpiResid E{X, X, X, mod, 8 * D, 0.5f}; pg8::gemm_phase<EpiResid, pg8::StaticOrder, true, true>(ldsl, g, S, E); }
    GSYNC();
#endif
    final_norm_rows(X, a.in[24], a.out, gw, NGW, lane);
}

extern "C" void kernel_launch(void* const* d_in, const int* in_sizes, int n_in, void* d_out, int out_size, void* d_ws, size_t ws_size, hipStream_t stream) {
    static int grid = 0;
    if (grid == 0) {
        if (n_in != 25 || out_size != ML * D || ws_size < WS_END) { fprintf(stderr, "kernel_launch: unexpected shapes (n_in %d out %d ws %zu)\n", n_in, out_size, ws_size); grid = -1; return; }
        int dev = 0, cus = 0, per_cu = 0;
        hipGetDevice(&dev);
        hipDeviceGetAttribute(&cus, hipDeviceAttributeMultiprocessorCount, dev);
        hipFuncSetAttribute((const void*)mega, hipFuncAttributeMaxDynamicSharedMemorySize, LDS_BYTES);
        hipOccupancyMaxActiveBlocksPerMultiprocessor(&per_cu, (const void*)mega, NTHR, LDS_BYTES);
        if (per_cu < 1) fprintf(stderr, "kernel_launch: occupancy query says %d blocks per CU\n", per_cu);
        (void)hipGetLastError();
        grid = cus;
    }
    if (grid < 0) return;
    if (hipMemsetAsync((char*)d_ws + WS_BAR, 0, 16384, stream) != hipSuccess) { fprintf(stderr, "kernel_launch: memset of the barrier words failed\n"); return; }
    Args a{};
    for (int i = 0; i < 25; ++i) a.in[i] = (const float*)d_in[i];
    a.out = (float*)d_out; a.ws = (unsigned char*)d_ws;
    void* args[] = {&a};
    hipError_t e = hipLaunchCooperativeKernel((const void*)mega, dim3(grid), dim3(NTHR), args, LDS_BYTES, stream);
    if (e != hipSuccess) fprintf(stderr, "cooperative launch failed: %s (grid %d)\n", hipGetErrorString(e), grid);
}
```

```cpp
#include <hip/hip_runtime.h>
#include <hip/hip_cooperative_groups.h>
#include <cstdio>
#include <cstdint>
namespace cg = cooperative_groups;
#define STAGE 99
#define PROBE 0
namespace pg8 {
#define PG8_LAS __attribute__((address_space(3)))
typedef unsigned short bf16_t;
typedef short bf16x8 __attribute__((ext_vector_type(8)));
typedef float f32x4 __attribute__((ext_vector_type(4)));
typedef unsigned u32x4 __attribute__((ext_vector_type(4)));
constexpr int BM = 256, BK = 64, HALF = 128, HTB = HALF * BK * 2  , STAGE_BYTES = 8 * HTB, NXCD = 8, WGM = 8;

__host__ __device__ __forceinline__ int lds_byte(int r, int c) { const int st = (r >> 4) * 2 + (c >> 5), rr = r & 15, cc = c & 31, ob = rr * 64 + cc * 2; return st * 1024 + (ob ^ (((ob >> 9) & 1) << 5)); }
__host__ __device__ __forceinline__ void stage_rc(int b, int& R, int& C) { const int st = b / 1024, sb = b % 1024, swz = sb ^ (((sb >> 9) & 1) << 5); R = (st >> 1) * 16 + swz / 64; C = (st & 1) * 32 + (swz % 64) / 2; }
__host__ __device__ __forceinline__ int perm32(int rho) { const int n = rho >> 4, i = rho & 15; return 8 * (i >> 2) + 4 * n + (i & 3); }

struct Unit { int pm, pn, k0; };
struct Gemm { const bf16_t* A; const bf16_t* Bt; int M, N, K, ld; };

struct StaticOrder {
    int nM, nN, nwg, G, c;
    __host__ __device__ void init(int M, int N, int G_, int c_) { nM = M / BM; nN = N / BM; nwg = nM * nN; G = G_; c = c_; }
    __host__ __device__ bool next(int i, Unit& u) const {
        const long L = (long)i * G + c; if (L >= nwg) return false;
        int wgid = (int)L; { const int q = nwg / NXCD, r = nwg % NXCD, xcd = wgid % NXCD, off = wgid / NXCD; wgid = (xcd < r ? xcd * (q + 1) : r * (q + 1) + (xcd - r) * q) + off; }
        const int nig = WGM * nN, gid = wgid / nig, fm = gid * WGM, gsz = (nM - fm) < WGM ? (nM - fm) : WGM;
        u.pm = fm + ((wgid % nig) % gsz); u.pn = (wgid % nig) / gsz; u.k0 = 0; return true;
    }
    __device__ __forceinline__ void a_ready(const Unit&) const {}
    __device__ __forceinline__ void done(const Unit&) const {}
};

__device__ __forceinline__ unsigned cvt_pk_bf16(float lo, float hi) { unsigned r; asm volatile("v_cvt_pk_bf16_f32 %0, %1, %2" : "=v"(r) : "v"(lo), "v"(hi)); return r; }
typedef float f32x2 __attribute__((ext_vector_type(2)));
__device__ __forceinline__ f32x2 gelu_pk(f32x2 v) {
    const f32x2 av = __builtin_elementwise_abs(v), d = av * 0.2316418882f + 1.0f;
    f32x2 t; t.x = __builtin_amdgcn_rcpf(d.x); t.y = __builtin_amdgcn_rcpf(d.y);
    f32x2 q = t * 0.5307027145f + (-0.7265760135f); q = q * t + 0.7107068705f; q = q * t + (-0.142248368f); q = q * t + 0.127414796f; q = q * t;
    const f32x2 s = (v * v) * (-0.72134752044f);
    f32x2 e; e.x = __builtin_amdgcn_exp2f(s.x); e.y = __builtin_amdgcn_exp2f(s.y);
    const f32x2 m = v * (q * e), r = v - m;
    f32x2 o; o.x = v.x < 0.f ? m.x : r.x; o.y = v.y < 0.f ? m.y : r.y; return o;
}

template <class Epi, class Sched, bool ALIGN_EPI = false, bool SP2 = false>
__device__ __forceinline__ void gemm_phase(PG8_LAS unsigned char* lds, const Gemm g, const Sched& S, const Epi& E) {
    const int tid = threadIdx.x, wid = __builtin_amdgcn_readfirstlane(tid >> 6), lane = tid & 63, wr = wid >> 2, wc = wid & 3, fr = lane & 15, fq = lane >> 4;
    const int K = g.ld, nt = g.K / BK;
    unsigned voffA[2], voffB[2];
#pragma unroll
    for (int i = 0; i < 2; ++i) { int R, C; stage_rc(tid * 16 + i * 8192, R, C); const int Rb = Epi::PERM ? ((R & ~31) + perm32(R & 31)) : R;
        voffA[i] = (unsigned)(R * K + C) * 2u; voffB[i] = (unsigned)(Rb * K + C) * 2u; }
    const size_t kstep = (size_t)(BK * 2);
    const size_t hstep = (size_t)HALF * K * 2;
    const size_t tstep = 2 * hstep;
    const unsigned ldsw = (unsigned)wid * 1024u;
    const int aoff = lds_byte(wr * 64 + fr, fq * 8), boff = lds_byte(wc * 32 + fr, fq * 8);
#define PG8_SA(b, h) (((b) * 2 + (h)) * HTB)
#define PG8_SB(b, h) ((4 + (b) * 2 + (h)) * HTB)
#define PG8_STAGE(bufoff, gbase, voff) do { _Pragma("unroll") for (int _i = 0; _i < 2; ++_i) \
        __builtin_amdgcn_global_load_lds((const unsigned*)((const char*)(gbase) + (voff)[_i]), (PG8_LAS unsigned*)(lds + (bufoff) + ldsw + _i * 8192), 16, 0, 0); } while (0)
#define PG8_LDA(dst, b, h) do { _Pragma("unroll") for (int m = 0; m < 4; ++m) _Pragma("unroll") for (int k = 0; k < 2; ++k) dst[m][k] = *(const PG8_LAS bf16x8*)(lds + PG8_SA(b, h) + aoff + m * 2048 + k * 1024); } while (0)
#define PG8_LDB(dst, b, h) do { _Pragma("unroll") for (int n = 0; n < 2; ++n) _Pragma("unroll") for (int k = 0; k < 2; ++k) dst[n][k] = *(const PG8_LAS bf16x8*)(lds + PG8_SB(b, h) + boff + n * 2048 + k * 1024); } while (0)
#define PG8_MMA(ai, bj, At, Bt) do { __builtin_amdgcn_s_setprio(1); _Pragma("unroll") for (int m = 0; m < 4; ++m) _Pragma("unroll") for (int n = 0; n < 2; ++n) _Pragma("unroll") for (int k = 0; k < 2; ++k) \
        acc[ai][bj][m][n] = __builtin_amdgcn_mfma_f32_16x16x32_bf16(Bt[n][k], At[m][k], acc[ai][bj][m][n], 0, 0, 0); __builtin_amdgcn_s_setprio(0); } while (0)
#define PG8_WAIT_V(n) asm volatile("s_waitcnt vmcnt(" #n ")" ::: "memory")
#define PG8_WAIT_L(n) asm volatile("s_waitcnt lgkmcnt(" #n ")" ::: "memory")
#define PG8_BAR __builtin_amdgcn_s_barrier()
#define PG8_SCHED __builtin_amdgcn_sched_barrier(0)
    Unit cur, nxt; int ui = 0;
    if (!S.next(0, cur)) return;
    f32x4 acc[2][2][4][2];
#pragma unroll
    for (int a = 0; a < 2; ++a)
#pragma unroll
        for (int b = 0; b < 2; ++b)
#pragma unroll
            for (int m = 0; m < 4; ++m)
#pragma unroll
                for (int n = 0; n < 2; ++n) acc[a][b][m][n] = (f32x4){0.f, 0.f, 0.f, 0.f};
    bf16x8 At[4][2], B0[2][2], B1[2][2];
    const char* cA = (const char*)g.A + (size_t)cur.pm * tstep + (size_t)cur.k0 * 2; const char* cB = (const char*)g.Bt + (size_t)cur.pn * tstep + (size_t)cur.k0 * 2;
    S.a_ready(cur);
    if constexpr (SP2) {
        PG8_STAGE(PG8_SB(0, 0), cB, voffB); PG8_STAGE(PG8_SB(0, 1), cB + hstep, voffB); PG8_STAGE(PG8_SA(0, 0), cA, voffA); PG8_STAGE(PG8_SA(0, 1), cA + hstep, voffA);
        if (wr == 1) PG8_BAR;
        PG8_WAIT_V(2); PG8_BAR;
        PG8_STAGE(PG8_SB(1, 0), cB + kstep, voffB); PG8_STAGE(PG8_SA(1, 0), cA + kstep, voffA); PG8_STAGE(PG8_SB(1, 1), cB + hstep + kstep, voffB);
        PG8_WAIT_V(6); PG8_BAR;
    } else {
        PG8_STAGE(PG8_SB(0, 0), cB, voffB); PG8_STAGE(PG8_SA(0, 0), cA, voffA); PG8_STAGE(PG8_SB(0, 1), cB + hstep, voffB); PG8_STAGE(PG8_SA(0, 1), cA + hstep, voffA);
        if (wr == 1) PG8_BAR;
        PG8_WAIT_V(4); PG8_BAR;
        PG8_STAGE(PG8_SB(1, 0), cB + kstep, voffB); PG8_STAGE(PG8_SA(1, 0), cA + kstep, voffA); PG8_STAGE(PG8_SB(1, 1), cB + hstep + kstep, voffB);
        PG8_WAIT_V(6); PG8_BAR;
    }
    for (;;) {
        const bool has_next = S.next(ui + 1, nxt);
        const char* nA = has_next ? (const char*)g.A + (size_t)nxt.pm * tstep + (size_t)nxt.k0 * 2 : cA; const char* nB = has_next ? (const char*)g.Bt + (size_t)nxt.pn * tstep + (size_t)nxt.k0 * 2 : cB;
        for (int t = 0; t < nt; t += 2) {
            const bool last = (t == nt - 2);
            const char* a1 = cA + (size_t)(t + 1) * kstep;
            const char* a2 = last ? nA : cA + (size_t)(t + 2) * kstep; const char* b2 = last ? nB : cB + (size_t)(t + 2) * kstep;
            const char* a3 = a2 + kstep; const char* b3 = b2 + kstep;
            if (last && has_next) S.a_ready(nxt);
            if constexpr (SP2) {
            PG8_LDB(B0, 0, 0); PG8_LDB(B1, 0, 1); PG8_SCHED; PG8_LDA(At, 0, 0); PG8_STAGE(PG8_SA(1, 1), a1 + hstep, voffA);
            PG8_WAIT_V(8); PG8_WAIT_L(0); PG8_BAR; PG8_MMA(0, 0, At, B0); PG8_MMA(0, 1, At, B1); PG8_BAR; PG8_SCHED;
            PG8_LDA(At, 0, 1); PG8_STAGE(PG8_SB(0, 0), b2, voffB); PG8_STAGE(PG8_SB(0, 1), b2 + hstep, voffB); PG8_STAGE(PG8_SA(0, 0), a2, voffA);
            PG8_WAIT_V(8); PG8_WAIT_L(0); PG8_BAR; PG8_MMA(1, 0, At, B0); PG8_MMA(1, 1, At, B1); PG8_BAR; PG8_SCHED;
            PG8_LDB(B0, 1, 0); PG8_LDB(B1, 1, 1); PG8_SCHED; PG8_LDA(At, 1, 0); PG8_STAGE(PG8_SA(0, 1), a2 + hstep, voffA);
            PG8_WAIT_V(8); PG8_WAIT_L(0); PG8_BAR; PG8_MMA(0, 0, At, B0); PG8_MMA(0, 1, At, B1); PG8_BAR; PG8_SCHED;
            PG8_LDA(At, 1, 1); PG8_STAGE(PG8_SB(1, 0), b3, voffB); PG8_STAGE(PG8_SB(1, 1), b3 + hstep, voffB); PG8_STAGE(PG8_SA(1, 0), a3, voffA);
            PG8_WAIT_V(8); PG8_WAIT_L(0); PG8_BAR; PG8_MMA(1, 0, At, B0); PG8_MMA(1, 1, At, B1); PG8_BAR; PG8_SCHED;
            } else {
            PG8_LDB(B0, 0, 0); PG8_SCHED; PG8_LDA(At, 0, 0); PG8_STAGE(PG8_SA(1, 1), a1 + hstep, voffA);
            PG8_WAIT_L(8); PG8_BAR; PG8_WAIT_L(0); PG8_MMA(0, 0, At, B0); PG8_BAR; PG8_SCHED;
            PG8_LDB(B1, 0, 1); PG8_STAGE(PG8_SB(0, 0), b2, voffB);
            PG8_BAR; PG8_WAIT_L(0); PG8_MMA(0, 1, At, B1); PG8_BAR;
            PG8_LDA(At, 0, 1); PG8_STAGE(PG8_SA(0, 0), a2, voffA);
            PG8_BAR; PG8_WAIT_L(0); PG8_MMA(1, 0, At, B0); PG8_BAR; PG8_SCHED;
            PG8_STAGE(PG8_SB(0, 1), b2 + hstep, voffB);
            PG8_WAIT_V(6); PG8_BAR; PG8_MMA(1, 1, At, B1); PG8_BAR;
            PG8_LDB(B0, 1, 0); PG8_SCHED; PG8_LDA(At, 1, 0); PG8_STAGE(PG8_SA(0, 1), a2 + hstep, voffA);
            PG8_WAIT_L(8); PG8_BAR; PG8_WAIT_L(0); PG8_MMA(0, 0, At, B0); PG8_BAR; PG8_SCHED;
            PG8_LDB(B1, 1, 1); PG8_STAGE(PG8_SB(1, 0), b3, voffB);
            PG8_BAR; PG8_WAIT_L(0); PG8_MMA(0, 1, At, B1); PG8_BAR;
            PG8_LDA(At, 1, 1); PG8_STAGE(PG8_SA(1, 0), a3, voffA);
            PG8_BAR; PG8_WAIT_L(0); PG8_MMA(1, 0, At, B0); PG8_BAR; PG8_SCHED;
            PG8_STAGE(PG8_SB(1, 1), b3 + hstep, voffB);
            PG8_WAIT_V(6); PG8_BAR; PG8_MMA(1, 1, At, B1); PG8_BAR;
            }
        }
        if constexpr (ALIGN_EPI) { if (wr == 0) PG8_BAR; }
        if constexpr (!Epi::AFTER_DRAIN) { E(acc, cur, wr, wc, fr, fq); S.done(cur); }
        if (!has_next) break;
#pragma unroll
        for (int a = 0; a < 2; ++a)
#pragma unroll
            for (int b = 0; b < 2; ++b)
#pragma unroll
                for (int m = 0; m < 4; ++m)
#pragma unroll
                    for (int n = 0; n < 2; ++n) acc[a][b][m][n] = (f32x4){0.f, 0.f, 0.f, 0.f};
        cur = nxt; cA = nA; cB = nB; ++ui;
        if constexpr (ALIGN_EPI) { if (wr == 1) PG8_BAR; }
    }
    PG8_WAIT_V(0);
    if constexpr (!ALIGN_EPI) { if (wr == 0) PG8_BAR; }
    PG8_BAR;
    if constexpr (Epi::AFTER_DRAIN) { E.fused(acc, cur, wr, wc, fr, fq, lds, wid, lane); S.done(cur); }
#undef PG8_SA
#undef PG8_SB
#undef PG8_STAGE
#undef PG8_LDA
#undef PG8_LDB
#undef PG8_MMA
#undef PG8_WAIT_V
#undef PG8_WAIT_L
#undef PG8_BAR
#undef PG8_SCHED
}
}
#define LAS __attribute__((address_space(3)))
#define XB_TMO      128
#define XB_XCNT(j)  (256  + 64 * (j))
#define XB_XSUB(j)  (1280 + 64 * (j))
#define XB_XGEN(j)  (2304 + 64 * (j))
#define XB_TOP      3328
#define XB_TOPGEN   3392
#define XCD_BAR_WORDS 3456
#define XB_SPIN_CAP (1u << 18)

__device__ __forceinline__ unsigned xb_ld(unsigned* p)              { return __hip_atomic_load(p, __ATOMIC_RELAXED, __HIP_MEMORY_SCOPE_AGENT); }
__device__ __forceinline__ unsigned xb_add(unsigned* p, unsigned v) { return __hip_atomic_fetch_add(p, v, __ATOMIC_RELAXED, __HIP_MEMORY_SCOPE_AGENT); }
__device__ __forceinline__ unsigned xb_xcc_id() { return (unsigned)__builtin_amdgcn_s_getreg((3 << 11) | 20) & 0xFu; }
#define XB_SPIN(cond, bar) do { unsigned _sp = 0; while (cond) { __builtin_amdgcn_s_sleep(1); \
    if ((++_sp & 255u) == 0u) { if (xb_ld(&(bar)[XB_TMO])) break; if (_sp > XB_SPIN_CAP) { atomicAdd(&(bar)[XB_TMO], 1u); break; } } } } while (0)

struct XcdBarrier {
    unsigned* bar; unsigned x;
    volatile LAS unsigned* st;
};

__device__ __forceinline__ XcdBarrier xcd_barrier_post(unsigned* bar, volatile LAS unsigned* st) {
    XcdBarrier b; b.bar = bar; b.x = xb_xcc_id(); b.st = st;
    if (threadIdx.x == 0) (void)xb_add(&bar[XB_XCNT(b.x)], 1u);
    return b;
}
__device__ __forceinline__ void xcd_barrier_complete(unsigned* bar, unsigned x, unsigned& nloc, unsigned& nx) {
    const unsigned G = gridDim.x * gridDim.y * gridDim.z;
    unsigned sum, cnt, mine, sp = 0u;
    for (;;) {
        sum = 0u; cnt = 0u; mine = 0u;
#pragma unroll
        for (unsigned j = 0; j < 16; ++j) { const unsigned c = xb_ld(&bar[XB_XCNT(j)]); sum += c; cnt += (c > 0u) ? 1u : 0u; mine = (j == x) ? c : mine; }
        if (sum == G) break;
        __builtin_amdgcn_s_sleep(1);
        if ((++sp & 255u) == 0u) { if (xb_ld(&bar[XB_TMO])) break; if (sp > XB_SPIN_CAP) { atomicAdd(&bar[XB_TMO], 1u); break; } }
    }
    nloc = mine > 0u ? mine : 1u; nx = cnt > 0u ? cnt : 1u;
}

__device__ __forceinline__ void xcd_barrier(const XcdBarrier& b) {
    asm volatile("s_waitcnt vmcnt(0)" ::: "memory");
    __syncthreads();
    if (threadIdx.x == 0) {
        unsigned* bar = b.bar;
        __builtin_amdgcn_s_waitcnt(0);
        unsigned nloc = b.st[0], nx = b.st[1];
        if (nloc == 0u) { xcd_barrier_complete(bar, b.x, nloc, nx); b.st[0] = nloc; b.st[1] = nx; }
        const unsigned old = xb_add(&bar[XB_XSUB(b.x)], 1u);
        const unsigned gen = old / nloc;
        if (old + 1u == (gen + 1u) * nloc) {
            __builtin_amdgcn_fence(__ATOMIC_RELEASE, "agent");
            asm volatile("s_waitcnt vmcnt(0)" ::: "memory");
            const unsigned og = xb_add(&bar[XB_TOP], 1u);
            const unsigned tg = og / nx;
            if (og + 1u == (tg + 1u) * nx) xb_add(&bar[XB_TOPGEN], 1u);
            else XB_SPIN(xb_ld(&bar[XB_TOPGEN]) == tg, bar);
            __builtin_amdgcn_fence(__ATOMIC_ACQUIRE, "agent");
            xb_add(&bar[XB_XGEN(b.x)], 1u);
            asm volatile("s_waitcnt vmcnt(0)" ::: "memory");
        } else {
            XB_SPIN(xb_ld(&bar[XB_XGEN(b.x)]) == gen, bar);
            __builtin_amdgcn_fence(__ATOMIC_ACQUIRE, "agent");
            asm volatile("s_waitcnt vmcnt(0)" ::: "memory");
        }
    }
    __syncthreads();
}
using pg8::bf16_t; using pg8::bf16x8; using pg8::f32x4; using pg8::u32x4;

constexpr int NTHR = 512, LDS_BYTES = 147456;
constexpr int D = 2048, SEQ = 4096, BATCH = 2, CTXL = 256, DFF = 5632, DIN = 5152, DINP = 5376;
constexpr int ML = BATCH * SEQ, MC = BATCH * CTXL, MT = ML + MC;
constexpr int NMOD = 9 * D;
constexpr float EPS = 1e-6f;
constexpr int PC_LX = 0, PC_LG = 1024, PC_Q = 2048, PC_K = 2560, PC_V = 3072, PC_O = 4096, PC_GT = 5120;
constexpr size_t MiB = 1u << 20;
constexpr size_t WS_MOD = 0, WS_WG = 1 * MiB, WS_WUP1 = 2 * MiB, WS_WDN1 = 46 * MiB, WS_WIN = 68 * MiB, WS_WOUT = 89 * MiB, WS_WUP2 = 97 * MiB, WS_WDN2 = 141 * MiB,
    WS_XN = 163 * MiB, WS_ACT = 197 * MiB  , WS_X = 291 * MiB, WS_G = 359 * MiB, WS_HL = 361 * MiB, WS_AC = 393 * MiB,
    WS_CSUM = 425 * MiB, WS_CARRY = 428 * MiB, WS_CST = 429 * MiB, WS_MSC = 464 * MiB, WS_YA = 465 * MiB, WS_CPREV = 497 * MiB, WS_END = 530 * MiB;
constexpr int CSTE = 8256;

struct Args { const float* in[25]; float* out; unsigned char* ws; int never, pad; };
constexpr size_t WS_BAR = WS_MOD + 512 * 1024;

__device__ __forceinline__ unsigned pk2(float lo, float hi) { return pg8::cvt_pk_bf16(lo, hi); }
__device__ __forceinline__ unsigned short f2bf(float f) { return (unsigned short)(pg8::cvt_pk_bf16(f, 0.f) & 0xffffu); }
__device__ __forceinline__ float bflo(unsigned w) { return __uint_as_float(w << 16); }
__device__ __forceinline__ float bfhi(unsigned w) { return __uint_as_float(w & 0xffff0000u); }
__device__ __forceinline__ float bf2f(unsigned short h) { return __uint_as_float((unsigned)h << 16); }
__device__ __forceinline__ float sigmoidf_(float x) { return 1.0f / (1.0f + __expf(-x)); }
__device__ __forceinline__ float siluf_(float x) { return x / (1.0f + __expf(-x)); }
__device__ __forceinline__ float logsigmoidf_(float x) { return fminf(x, 0.f) - log1pf(__expf(-fabsf(x))); }
__device__ __forceinline__ float gelu_tanhf_(float x) { const float u = 0.7978845608028654f * (x + 0.044715f * x * x * x); return 0.5f * x * (1.0f + tanhf(u)); }
__device__ __forceinline__ float wave_sum(float v) {
#pragma unroll
    for (int o = 1; o < 64; o <<= 1) v += __shfl_xor(v, o);
    return v;
}
__device__ __forceinline__ float wave_max(float v) {
#pragma unroll
    for (int o = 1; o < 64; o <<= 1) v = fmaxf(v, __shfl_xor(v, o));
    return v;
}
__device__ __forceinline__ float wave_incl_sum(float v, int lane) {
#pragma unroll
    for (int o = 1; o < 64; o <<= 1) { const float t = __shfl_up(v, o); if (lane >= o) v += t; }
    return v;
}
__device__ __forceinline__ float wave_incl_max(float v, int lane) {
#pragma unroll
    for (int o = 1; o < 64; o <<= 1) { const float t = __shfl_up(v, o); if (lane >= o) v = fmaxf(v, t); }
    return v;
}
__device__ __forceinline__ bf16x8 pack8(const float* p) {
    const f32x4 a = *(const f32x4*)p, b = *(const f32x4*)(p + 4);
    u32x4 w; w.x = pk2(a.x, a.y); w.y = pk2(a.z, a.w); w.z = pk2(b.x, b.y); w.w = pk2(b.z, b.w);
    return __builtin_bit_cast(bf16x8, w);
}
#define MFMA16(a, b, c) __builtin_amdgcn_mfma_f32_16x16x32_bf16((a), (b), (c), 0, 0, 0)

struct EpiSwiglu {
    static constexpr bool PERM = true, AFTER_DRAIN = false;
    bf16_t* O; int ldc;
    __device__ __forceinline__ void operator()(const f32x4 (&acc)[2][2][4][2], const pg8::Unit& u, int wr, int wc, int fr, int fq) const {
        const int row0 = u.pm * 256 + wr * 64 + fr, col0 = u.pn * 128 + wc * 32 + 8 * fq;
#pragma unroll
        for (int ai = 0; ai < 2; ++ai)
#pragma unroll
            for (int m = 0; m < 4; ++m) {
                bf16_t* rowp = O + (size_t)(row0 + ai * 128 + m * 16) * ldc + col0;
                const f32x4 g0 = acc[ai][0][m][0], g1 = acc[ai][0][m][1], u0 = acc[ai][1][m][0], u1 = acc[ai][1][m][1];
                u32x4 w;
                w.x = pk2(siluf_(g0[0]) * u0[0], siluf_(g0[1]) * u0[1]); w.y = pk2(siluf_(g0[2]) * u0[2], siluf_(g0[3]) * u0[3]);
                w.z = pk2(siluf_(g1[0]) * u1[0], siluf_(g1[1]) * u1[1]); w.w = pk2(siluf_(g1[2]) * u1[2], siluf_(g1[3]) * u1[3]);
                *(u32x4*)rowp = w;
            }
    }
};
struct EpiResid {
    static constexpr bool PERM = false, AFTER_DRAIN = false;
    const float* baseL; const float* baseC; float* out; const float* mod; int goff; float scale; float* part;
    __device__ __forceinline__ void operator()(const f32x4 (&acc)[2][2][4][2], const pg8::Unit& u, int wr, int wc, int fr, int fq) const {
        const int rowt = u.pm * 256; const int mr = rowt < ML ? (rowt >> 12) : 2;
        const float* bp = rowt < ML ? baseL : baseC - (size_t)ML * D;
        const float* gp = mod + (size_t)mr * NMOD + goff;
        const int col0 = u.pn * 256 + wc * 32 + 4 * fq;
        const bool isp = part != nullptr;
        float* op = isp ? part + (size_t)(u.k0 >> 9) * ((size_t)MC * D) - (size_t)ML * D : out;
#pragma unroll
        for (int bj = 0; bj < 2; ++bj)
#pragma unroll
            for (int n = 0; n < 2; ++n) {
                const int c = col0 + bj * 128 + n * 16;
                f32x4 gv = *(const f32x4*)(gp + c) * scale;
                if (isp) gv = (f32x4){1.f, 1.f, 1.f, 1.f};
#pragma unroll
                for (int ai = 0; ai < 2; ++ai)
#pragma unroll
                    for (int m = 0; m < 4; ++m) {
                        const size_t off = (size_t)(rowt + ai * 128 + wr * 64 + m * 16 + fr) * D + c;
                        f32x4 bs = {0.f, 0.f, 0.f, 0.f};
                        if (!isp) bs = *(const f32x4*)(bp + off);
                        *(f32x4*)(op + off) = bs + gv * acc[ai][bj][m][n];
                    }
                asm volatile("" ::: "memory");
            }
    }
};
struct EpiInProj {
    static constexpr bool PERM = true, AFTER_DRAIN = false;
    bf16_t* P; float* G; const float* bm;
    __device__ __forceinline__ void operator()(const f32x4 (&acc)[2][2][4][2], const pg8::Unit& u, int wr, int wc, int fr, int fq) const {
        const int row0 = u.pm * 256 + wr * 64 + fr, col0 = u.pn * 256 + wc * 32 + 8 * fq;
        const bool gates = (u.pn == PC_GT / 256) && (wc == 0);
#pragma unroll
        for (int ai = 0; ai < 2; ++ai)
#pragma unroll
            for (int m = 0; m < 4; ++m) {
                const int row = row0 + ai * 128 + m * 16;
                bf16_t* rowp = P + (size_t)row * DINP + col0;
#pragma unroll
                for (int bj = 0; bj < 2; ++bj) {
                    const f32x4 v0 = acc[ai][bj][m][0], v1 = acc[ai][bj][m][1];
                    u32x4 w; w.x = pk2(v0[0], v0[1]); w.y = pk2(v0[2], v0[3]); w.z = pk2(v1[0], v1[1]); w.w = pk2(v1[2], v1[3]);
                    *(u32x4*)(rowp + bj * 128) = w;
                }
                if (gates) {
                    const f32x4 b0 = *(const f32x4*)(bm + 8 * fq), b1 = *(const f32x4*)(bm + 8 * fq + 4);
                    *(f32x4*)(G + (size_t)row * 32 + 8 * fq) = acc[ai][0][m][0] + b0;
                    *(f32x4*)(G + (size_t)row * 32 + 8 * fq + 4) = acc[ai][0][m][1] + b1;
                }
            }
    }
};

struct EpiPartial {
    static constexpr bool PERM = false, AFTER_DRAIN = false;
    float* part;
    __device__ __forceinline__ void operator()(const f32x4 (&acc)[2][2][4][2], const pg8::Unit& u, int wr, int wc, int fr, int fq) const {
        float* base = part + (size_t)(u.k0 >> 9) * ((size_t)MC * D) + (size_t)(u.pm * 256 - ML) * D;
        const int col0 = u.pn * 256 + wc * 32 + 4 * fq;
#pragma unroll
        for (int bj = 0; bj < 2; ++bj)
#pragma unroll
            for (int n = 0; n < 2; ++n) {
#pragma unroll
                for (int ai = 0; ai < 2; ++ai)
#pragma unroll
                    for (int m = 0; m < 4; ++m) *(f32x4*)(base + (size_t)(ai * 128 + wr * 64 + m * 16 + fr) * D + col0 + bj * 128 + n * 16) = acc[ai][bj][m][n];
                asm volatile("" ::: "memory");
            }
    }
};
constexpr int NSPLIT = 11, KSPLIT = DFF / NSPLIT;
struct SplitOrder {
    int G, c;
    __device__ void init(int G_, int c_) { G = G_; c = c_; }
    __device__ bool next(int i, pg8::Unit& u) const { const int L = i * G + c; if (L >= 16 * NSPLIT) return false; const int sp = L % NSPLIT, t = L / NSPLIT; u.pm = ML / 256 + (t >> 3); u.pn = t & 7; u.k0 = sp * KSPLIT; return true; }
    __device__ __forceinline__ void a_ready(const pg8::Unit&) const {}
    __device__ __forceinline__ void done(const pg8::Unit&) const {}
};

__device__ __forceinline__ void transpose_item(const float* __restrict__ W, int K, int N, bf16_t* __restrict__ WT, int k0, int n0, int drow0, float* scr, int lane) {
#pragma unroll 8
    for (int i = 0; i < 32; ++i) { const int kk = 2 * i + (lane >> 5); scr[kk * 33 + (lane & 31)] = W[(size_t)(k0 + kk) * N + n0 + (lane & 31)]; }
    __builtin_amdgcn_s_waitcnt(0); asm volatile("" ::: "memory");
    const int c = lane & 7;
#pragma unroll
    for (int j = 0; j < 4; ++j) { const int n = (lane >> 3) + 8 * j; const float* s = scr + (8 * c) * 33 + n;
        u32x4 o; o.x = pk2(s[0 * 33], s[1 * 33]); o.y = pk2(s[2 * 33], s[3 * 33]); o.z = pk2(s[4 * 33], s[5 * 33]); o.w = pk2(s[6 * 33], s[7 * 33]);
        *(u32x4*)(WT + (size_t)(drow0 + n) * K + k0 + 8 * c) = o; }
    __builtin_amdgcn_s_waitcnt(0); asm volatile("" ::: "memory");
}
__device__ __forceinline__ int swiglu_row(int n0) {
    return n0 < DFF ? 256 * (n0 >> 7) + (n0 & 127) : 256 * ((n0 - DFF) >> 7) + 128 + ((n0 - DFF) & 127);
}
constexpr int T_UP = 32 * 352, T_DN = 88 * 64, T_IN = 32 * 161, T_OUT = 32 * 64, T_G = 256;
constexpr int T_ALL = 2 * T_UP + 2 * T_DN + T_IN + T_OUT + T_G;
__device__ __forceinline__ void p0_item(const Args& a, int it, float* scr, int lane) {
    unsigned char* ws = a.ws;
    if (it < 2 * T_UP) { const int w = it >= T_UP; const int r = it - w * T_UP; const int kb = r / 352, nb = r % 352;
        transpose_item(a.in[w ? 22 : 7], D, 2 * DFF, (bf16_t*)(ws + (w ? WS_WUP2 : WS_WUP1)), 64 * kb, 32 * nb, swiglu_row(32 * nb), scr, lane); return; }
    it -= 2 * T_UP;
    if (it < 2 * T_DN) { const int w = it >= T_DN; const int r = it - w * T_DN; const int kb = r / 64, nb = r % 64;
        transpose_item(a.in[w ? 23 : 8], DFF, D, (bf16_t*)(ws + (w ? WS_WDN2 : WS_WDN1)), 64 * kb, 32 * nb, 32 * nb, scr, lane); return; }
    it -= 2 * T_DN;
    if (it < T_IN) { const int kb = it / 161, nb = it % 161; transpose_item(a.in[10], D, DIN, (bf16_t*)(ws + WS_WIN), 64 * kb, 32 * nb, 32 * nb, scr, lane); return; }
    it -= T_IN;
    if (it < T_OUT) { const int kb = it / 64, nb = it % 64; transpose_item(a.in[20], D, D, (bf16_t*)(ws + WS_WOUT), 64 * kb, 32 * nb, 32 * nb, scr, lane); return; }
    it -= T_OUT;
    { const int mi = it >> 3, sub = it & 7, g = mi >> 4, d = (mi >> 3) & 1, n = mi & 7;
      transpose_item(a.in[g ? 16 : 14] + (size_t)(d * 8 + n) * 16384, 128, 128, (bf16_t*)(ws + WS_WG) + (size_t)((n * 2 + d) * 2 + g) * 16384, 64 * (sub >> 2), 32 * (sub & 3), 32 * (sub & 3), scr, lane); }
}
__device__ __forceinline__ void phase0(const Args& a, unsigned char* lds, int tid, int lane, int wave) {
    const int G = gridDim.x, bx = blockIdx.x;
    float* sc = (float*)lds;
    float* red = (float*)(lds + 24576);
    float* mod = (float*)(a.ws + WS_MOD);
    if (bx < 144) {
        for (int i = tid; i < 3 * D; i += NTHR) { const int r = i >> 11, k = i & 2047; const float c = r < 2 ? a.in[1][r * D + k] : a.in[3][k]; sc[i] = siluf_(c); }
        __syncthreads();
        for (int it = bx; it < 144; it += G) {
            const float* w = a.in[4] + (size_t)(wave * 256) * NMOD + it * 128 + 2 * lane;
            float a00 = 0.f, a01 = 0.f, a10 = 0.f, a11 = 0.f, a20 = 0.f, a21 = 0.f;
#pragma unroll 8
            for (int k = 0; k < 256; ++k) {
                const float2 wv = *(const float2*)(w + (size_t)k * NMOD);
                const float s0 = sc[wave * 256 + k], s1 = sc[D + wave * 256 + k], s2 = sc[2 * D + wave * 256 + k];
                a00 += s0 * wv.x; a01 += s0 * wv.y; a10 += s1 * wv.x; a11 += s1 * wv.y; a20 += s2 * wv.x; a21 += s2 * wv.y;
            }
            red[(wave * 6 + 0) * 64 + lane] = a00; red[(wave * 6 + 1) * 64 + lane] = a01; red[(wave * 6 + 2) * 64 + lane] = a10;
            red[(wave * 6 + 3) * 64 + lane] = a11; red[(wave * 6 + 4) * 64 + lane] = a20; red[(wave * 6 + 5) * 64 + lane] = a21;
            __syncthreads();
            if (tid < 384) { const int r = tid >> 7, cc = tid & 127; float s = a.in[5][it * 128 + cc];
#pragma unroll
                for (int w8 = 0; w8 < 8; ++w8) s += red[(w8 * 6 + r * 2 + (cc & 1)) * 64 + (cc >> 1)];
                mod[(size_t)r * NMOD + it * 128 + cc] = s; }
            __syncthreads();
        }
    }
    __syncthreads();
    { u32x4* z = (u32x4*)((bf16_t*)(a.ws + WS_WIN) + (size_t)DIN * D); const int nz = (DINP - DIN) * D / 8;
      for (int i = bx * NTHR + tid; i < nz; i += G * NTHR) z[i] = (u32x4){0u, 0u, 0u, 0u}; }
    float* scr = (float*)(lds + wave * 16384);
    if (G == 256) {
        const int start = bx < 144 ? 106 * bx : 144 * 106 + 232 * (bx - 144), cnt = bx < 144 ? 106 : 232;
        for (int i = wave; i < cnt; i += 8) p0_item(a, start + i, scr, lane);
    } else {
        for (int it = bx * 8 + wave; it < T_ALL; it += G * 8) p0_item(a, it, scr, lane);
    }
}
static_assert(144 * 106 + 112 * 232 == T_ALL, "phase-0 split");

__device__ __forceinline__ void norm_mod_rows(const float* srcL, const float* srcC, int nrows, const float* gnorm, const float* mod, int sub, bf16_t* XN, int gw, int NGW, int lane, const float* part = nullptr, const float* pgate = nullptr) {
    for (int m = gw; m < nrows; m += NGW) {
        const float* xr = m < ML ? srcL + (size_t)m * D : srcC + (size_t)(m - ML) * D;
        const int mr = m < ML ? (m >> 12) : 2;
        const float* sh = mod + (size_t)mr * NMOD + (3 * sub) * D; const float* scl = sh + D;
        f32x4 v[8]; float s = 0.f;
#pragma unroll
        for (int j = 0; j < 8; ++j) v[j] = ((const f32x4*)xr)[lane + 64 * j];
        if (part != nullptr && m >= ML) {
#pragma unroll
            for (int j = 0; j < 8; ++j) { f32x4 ps = {0.f, 0.f, 0.f, 0.f};
#pragma unroll
                for (int sp = 0; sp < NSPLIT; ++sp) ps += ((const f32x4*)(part + (size_t)sp * ((size_t)MC * D) + (size_t)(m - ML) * D))[lane + 64 * j];
                v[j] += ((const f32x4*)pgate)[lane + 64 * j] * 0.5f * ps; }
        }
#pragma unroll
        for (int j = 0; j < 8; ++j) s += (v[j].x * v[j].x + v[j].y * v[j].y) + (v[j].z * v[j].z + v[j].w * v[j].w);
        const float r = 1.0f / sqrtf(wave_sum(s) * (1.0f / D) + EPS);
        unsigned long long* o8 = (unsigned long long*)(XN + (size_t)m * D) + lane;
#pragma unroll
        for (int j = 0; j < 8; ++j) {
            const f32x4 g = ((const f32x4*)gnorm)[lane + 64 * j], shv = ((const f32x4*)sh)[lane + 64 * j], scv = ((const f32x4*)scl)[lane + 64 * j];
            const f32x4 y = (v[j] * r * g) * (scv + 1.0f) + shv;
            o8[64 * j] = (unsigned long long)pk2(y.x, y.y) | ((unsigned long long)pk2(y.z, y.w) << 32);
        }
    }
}
__device__ __forceinline__ void final_norm_rows(const float* X, const float* gnorm, float* out, int gw, int NGW, int lane) {
    for (int m = gw; m < ML; m += NGW) {
        const f32x4* xr = (const f32x4*)(X + (size_t)m * D) + lane;
        f32x4 v[8]; float s = 0.f;
#pragma unroll
        for (int j = 0; j < 8; ++j) { v[j] = xr[64 * j]; s += (v[j].x * v[j].x + v[j].y * v[j].y) + (v[j].z * v[j].z + v[j].w * v[j].w); }
        const float r = 1.0f / sqrtf(wave_sum(s) * (1.0f / D) + EPS);
        f32x4* o = (f32x4*)(out + (size_t)m * D) + lane;
#pragma unroll
        for (int j = 0; j < 8; ++j) { const f32x4 g = ((const f32x4*)gnorm)[lane + 64 * j]; o[64 * j] = v[j] * r * g; }
    }
}

__device__ __forceinline__ void lru_local_item(unsigned char* lds, int item, const Args& a, int tid, int lane, int wave) {
    const bf16_t* P = (const bf16_t*)(a.ws + WS_ACT);
    const bf16_t* WG = (const bf16_t*)(a.ws + WS_WG);
    bf16_t* HL = (bf16_t*)(a.ws + WS_HL); bf16_t* AC = (bf16_t*)(a.ws + WS_AC);
    float* CSUM = (float*)(a.ws + WS_CSUM);
    float* XC = (float*)lds;
    float* LA = (float*)(lds + 33792);
    float* LB = (float*)(lds + 67584);
    float* SEG = (float*)(lds + 101376);
    const int n = item & 7, sc = item >> 3;
    int b, ck, rowbase, seqlen, chunkidx; bool islat;
    if (sc < 128) { b = sc >> 6; ck = sc & 63; rowbase = b * SEQ; seqlen = SEQ; islat = true; chunkidx = 4 + ck; }
    else { const int s2 = sc - 128; b = s2 >> 2; ck = s2 & 3; rowbase = ML + b * CTXL; seqlen = CTXL; islat = false; chunkidx = ck; }
    const int t0 = ck * 64;
    {
        const int tok = tid >> 3, c8 = tid & 7, ch0 = n * 128 + c8 * 16;
        float accv[16];
#pragma unroll
        for (int i = 0; i < 16; i += 4) { const f32x4 bb = *(const f32x4*)(a.in[13] + ch0 + i); accv[i] = bb.x; accv[i + 1] = bb.y; accv[i + 2] = bb.z; accv[i + 3] = bb.w; }
#pragma unroll
        for (int k = 0; k < 4; ++k) {
            const int t = t0 + tok + k - 2;
            if (t >= 0 && t < seqlen) {
                const u32x4* src = (const u32x4*)(P + (size_t)(rowbase + t) * DINP + PC_LX + ch0);
                const u32x4 x0 = src[0], x1 = src[1];
                const float* cw = a.in[12] + k * 1024 + ch0;
                const unsigned xw[8] = {x0.x, x0.y, x0.z, x0.w, x1.x, x1.y, x1.z, x1.w};
#pragma unroll
                for (int i = 0; i < 8; ++i) { accv[2 * i] += cw[2 * i] * bflo(xw[i]); accv[2 * i + 1] += cw[2 * i + 1] * bfhi(xw[i]); }
            }
        }
#pragma unroll
        for (int i = 0; i < 16; i += 4) *(f32x4*)(XC + tok * 132 + c8 * 16 + i) = (f32x4){accv[i], accv[i + 1], accv[i + 2], accv[i + 3]};
    }
    __syncthreads();
    const int fr = lane & 15, fq = lane >> 4;
#pragma unroll 1
    for (int d = 0; d < 2; ++d) {
        {
            const int col = 16 * wave + fr, ch = n * 128 + col;
            const bf16_t* wg = WG + (size_t)((n * 2 + d) * 2) * 16384 + (size_t)col * 128 + fq * 8;
            bf16x8 Br[4], Bi[4];
#pragma unroll
            for (int ks = 0; ks < 4; ++ks) { Br[ks] = *(const bf16x8*)(wg + ks * 32); Bi[ks] = *(const bf16x8*)(wg + 16384 + ks * 32); }
            const float brv = a.in[15][d * 1024 + ch], biv = a.in[17][d * 1024 + ch];
            const float sp = log1pf(__expf(-a.in[18][d * 1024 + ch]));
#pragma unroll
            for (int m = 0; m < 4; ++m) {
                f32x4 ar = {0.f, 0.f, 0.f, 0.f}, ai = {0.f, 0.f, 0.f, 0.f};
#pragma unroll
                for (int ks = 0; ks < 4; ++ks) { const bf16x8 A = pack8(XC + (16 * m + fr) * 132 + ks * 32 + fq * 8); ar = MFMA16(A, Br[ks], ar); ai = MFMA16(A, Bi[ks], ai); }
#pragma unroll
                for (int j = 0; j < 4; ++j) {
                    const int tok = 16 * m + 4 * fq + j;
                    const float r = sigmoidf_(ar[j] + brv), ii = sigmoidf_(ai[j] + biv);
                    const float la = -8.0f * r * sp, av = __expf(la), mult = sqrtf(fmaxf(-expm1f(2.0f * la), 0.f));
                    LA[tok * 132 + col] = av; LB[tok * 132 + col] = mult * ii * XC[tok * 132 + col];
                }
            }
        }
        __syncthreads();
        {
            const int seg = tid >> 7, ch = tid & 127;
            float hl[16], Al[16]; float h = 0.f, A = 1.f;
#pragma unroll
            for (int qi = 0; qi < 16; ++qi) { const int q = seg * 16 + qi, tok = d ? 63 - q : q; const float av = LA[tok * 132 + ch], bx = LB[tok * 132 + ch]; h = av * h + bx; A *= av; hl[qi] = h; Al[qi] = A; }
            SEG[(seg * 128 + ch) * 2] = A; SEG[(seg * 128 + ch) * 2 + 1] = h;
            __syncthreads();
            float carry = 0.f, Ap = 1.f;
#pragma unroll
            for (int s = 0; s < 3; ++s) if (s < seg) { const float As = SEG[(s * 128 + ch) * 2], hs = SEG[(s * 128 + ch) * 2 + 1]; carry = As * carry + hs; Ap *= As; }
            float Hlast = 0.f, Alast = 0.f;
#pragma unroll
            for (int qi = 0; qi < 16; ++qi) {
                const int q = seg * 16 + qi, tok = d ? 63 - q : q;
                const float H = hl[qi] + Al[qi] * carry, Ac = Al[qi] * Ap; Hlast = H; Alast = Ac;
                if (islat) { const size_t o = ((size_t)d * ML + rowbase + t0 + tok) * 1024 + n * 128 + ch; HL[o] = f2bf(H); AC[o] = f2bf(Ac); }
            }
            if (seg == 3) { const size_t o = ((size_t)((d * 2 + b) * 68 + chunkidx) * 2) * 1024 + n * 128 + ch; CSUM[o] = Alast; CSUM[o + 1024] = Hlast; }
        }
        __syncthreads();
    }
}

__device__ __forceinline__ void lru_carry(const Args& a, int gtid, int nthr) {
    const float* __restrict__ CSUM = (const float*)(a.ws + WS_CSUM);
    float* __restrict__ CARRY = (float*)(a.ws + WS_CARRY);
    for (int idx = gtid; idx < 4096; idx += nthr) {
        const int ch = idx & 1023, b = (idx >> 10) & 1, d = idx >> 11;
        const float* base = CSUM + (size_t)((d * 2 + b) * 68) * 2 * 1024 + ch;
        float carry = 0.f;
#pragma unroll 1
        for (int half = 0; half < 2; ++half) {
            float Av[34], hv[34];
#pragma unroll
            for (int s = 0; s < 34; ++s) { const int st = half * 34 + s; const int chunk = d == 0 ? st : (st < 4 ? 3 - st : 71 - st);
                Av[s] = base[(size_t)(chunk * 2) * 1024]; hv[s] = base[(size_t)(chunk * 2 + 1) * 1024]; }
#pragma unroll
            for (int s = 0; s < 34; ++s) { const int st = half * 34 + s; const int chunk = d == 0 ? st : (st < 4 ? 3 - st : 71 - st);
                if (chunk >= 4) CARRY[(size_t)((d * 2 + b) * 64 + (chunk - 4)) * 1024 + ch] = carry;
                carry = Av[s] * carry + hv[s]; }
        }
    }
}

__device__ __forceinline__ void lru_combine_rows(const Args& a, int gw, int NGW, int lane) {
    const bf16_t* P = (const bf16_t*)(a.ws + WS_ACT);
    const bf16_t* HL = (const bf16_t*)(a.ws + WS_HL); const bf16_t* AC = (const bf16_t*)(a.ws + WS_AC);
    const float* CARRY = (const float*)(a.ws + WS_CARRY);
    bf16_t* YA = (bf16_t*)(a.ws + WS_YA);
    for (int r = gw; r < ML; r += NGW) {
        const int b = r >> 12, ck = (r & 4095) >> 6;
#pragma unroll
        for (int jj = 0; jj < 2; ++jj) {
            const int ch = 8 * lane + 512 * jj;
            const u32x4 hf = *(const u32x4*)(HL + (size_t)r * 1024 + ch), af = *(const u32x4*)(AC + (size_t)r * 1024 + ch);
            const u32x4 hb = *(const u32x4*)(HL + ((size_t)ML + r) * 1024 + ch), ab = *(const u32x4*)(AC + ((size_t)ML + r) * 1024 + ch);
            const u32x4 lg = *(const u32x4*)(P + (size_t)r * DINP + PC_LG + ch);
            const float* cfp = CARRY + (size_t)((0 * 2 + b) * 64 + ck) * 1024 + ch; const float* cbp = CARRY + (size_t)((1 * 2 + b) * 64 + ck) * 1024 + ch;
            const f32x4 cf0 = *(const f32x4*)cfp, cf1 = *(const f32x4*)(cfp + 4), cb0 = *(const f32x4*)cbp, cb1 = *(const f32x4*)(cbp + 4);
            const float cf[8] = {cf0.x, cf0.y, cf0.z, cf0.w, cf1.x, cf1.y, cf1.z, cf1.w}, cb[8] = {cb0.x, cb0.y, cb0.z, cb0.w, cb1.x, cb1.y, cb1.z, cb1.w};
            const unsigned hfw[4] = {hf.x, hf.y, hf.z, hf.w}, afw[4] = {af.x, af.y, af.z, af.w}, hbw[4] = {hb.x, hb.y, hb.z, hb.w}, abw[4] = {ab.x, ab.y, ab.z, ab.w}, lgw[4] = {lg.x, lg.y, lg.z, lg.w};
            unsigned ow[4];
#pragma unroll
            for (int i = 0; i < 4; ++i) {
                const float r0 = bflo(hfw[i]) + bflo(afw[i]) * cf[2 * i] + bflo(hbw[i]) + bflo(abw[i]) * cb[2 * i];
                const float r1 = bfhi(hfw[i]) + bfhi(afw[i]) * cf[2 * i + 1] + bfhi(hbw[i]) + bfhi(abw[i]) * cb[2 * i + 1];
                ow[i] = pk2(gelu_tanhf_(bflo(lgw[i])) * r0, gelu_tanhf_(bfhi(lgw[i])) * r1);
            }
            *(u32x4*)(YA + (size_t)r * D + ch) = (u32x4){ow[0], ow[1], ow[2], ow[3]};
        }
    }
}

__device__ __forceinline__ int mrow_lat(int b, int p) { return b * SEQ + ((p & 63) << 6) + (p >> 6); }

__device__ __forceinline__ void mlstm_local_item(unsigned char* lds, int item, const Args& a, int tid, int lane, int wave) {
    const bf16_t* P = (const bf16_t*)(a.ws + WS_ACT);
    const float* Gt = (const float*)(a.ws + WS_G);
    float* CST = (float*)(a.ws + WS_CST); float* MSC = (float*)(a.ws + WS_MSC);
    bf16_t* VT = (bf16_t*)lds;
    bf16_t* KW = (bf16_t*)(lds + 34816);
    float* WGs = (float*)(lds + 69632);
    const int cidx = item % 34, bh = item / 34, h = bh & 7, b = bh >> 3;
    const int chain0 = (b * 8 + h) * 2;
#define MROW(j) (cidx < 2 ? ML + b * CTXL + cidx * 128 + (j) : mrow_lat(b, (cidx - 2) * 128 + (j)))
    if (wave < 2) {
        const int d = wave;
        const int j0 = d ? 127 - 2 * lane : 2 * lane, j1 = d ? 126 - 2 * lane : 2 * lane + 1;
        const float* g0p = Gt + (size_t)MROW(j0) * 32 + h; const float* g1p = Gt + (size_t)MROW(j1) * 32 + h;
        const float ig0 = g0p[(2 * d) * 8], fg0 = g0p[(2 * d + 1) * 8], ig1 = g1p[(2 * d) * 8], fg1 = g1p[(2 * d + 1) * 8];
        const float l0 = logsigmoidf_(fg0), l1 = logsigmoidf_(fg1);
        const float s1 = l0 + l1, incl = wave_incl_sum(s1, lane), excl = incl - s1, bc0 = excl + l0, bc1 = excl + s1;
        const float blast = __shfl(incl, 63);
        const float gg0 = blast - bc0 + ig0, gg1 = blast - bc1 + ig1;
        const float mloc = wave_max(fmaxf(gg0, gg1));
        WGs[d * 128 + j0] = __expf(gg0 - mloc); WGs[d * 128 + j1] = __expf(gg1 - mloc);
        if (lane == 0) { MSC[(size_t)((chain0 + d) * 34 + cidx) * 2] = mloc; MSC[(size_t)((chain0 + d) * 34 + cidx) * 2 + 1] = blast; }
    }
    const int j = tid >> 2, q4 = tid & 3; const size_t prow = (size_t)MROW(j) * DINP;
    {
        const u32x4* vs = (const u32x4*)(P + prow + PC_V + h * 128 + q4 * 32);
#pragma unroll
        for (int c = 0; c < 4; ++c) { const u32x4 x = vs[c]; const unsigned xw[4] = {x.x, x.y, x.z, x.w};
#pragma unroll
            for (int i = 0; i < 4; ++i) { VT[(q4 * 32 + c * 8 + 2 * i) * 136 + j] = (bf16_t)(xw[i] & 0xffffu); VT[(q4 * 32 + c * 8 + 2 * i + 1) * 136 + j] = (bf16_t)(xw[i] >> 16); } }
    }
    const u32x4* ks_ = (const u32x4*)(P + prow + PC_K + h * 64 + q4 * 16);
    const u32x4 k0 = ks_[0], k1 = ks_[1];
    __syncthreads();
    {
        const unsigned kw[8] = {k0.x, k0.y, k0.z, k0.w, k1.x, k1.y, k1.z, k1.w};
#pragma unroll
        for (int d = 0; d < 2; ++d) { const float w = WGs[d * 128 + j] * 0.125f;
#pragma unroll
            for (int i = 0; i < 8; ++i) { KW[(d * 64 + q4 * 16 + 2 * i) * 136 + j] = f2bf(bflo(kw[i]) * w); KW[(d * 64 + q4 * 16 + 2 * i + 1) * 136 + j] = f2bf(bfhi(kw[i]) * w); } }
    }
    __syncthreads();
    const int fr = lane & 15, fq = lane >> 4;
#pragma unroll
    for (int d = 0; d < 2; ++d) {
        f32x4 acc[4];
#pragma unroll
        for (int nt = 0; nt < 4; ++nt) acc[nt] = (f32x4){0.f, 0.f, 0.f, 0.f};
#pragma unroll
        for (int ks = 0; ks < 4; ++ks) {
            const bf16x8 A = *(const bf16x8*)(VT + (16 * wave + fr) * 136 + ks * 32 + fq * 8);
#pragma unroll
            for (int nt = 0; nt < 4; ++nt) { const bf16x8 B = *(const bf16x8*)(KW + (d * 64 + 16 * nt + fr) * 136 + ks * 32 + fq * 8); acc[nt] = MFMA16(A, B, acc[nt]); }
        }
        float* dst = CST + (size_t)((chain0 + d) * 34 + cidx) * CSTE;
#pragma unroll
        for (int nt = 0; nt < 4; ++nt)
#pragma unroll
            for (int i = 0; i < 4; ++i) dst[(16 * wave + 4 * fq + i) * 64 + 16 * nt + fr] = acc[nt][i];
    }
    if (tid < 128) { const int d = tid >> 6, k = tid & 63; float s = 0.f;
        for (int jj = 0; jj < 128; jj += 2) { const unsigned w = *(const unsigned*)(KW + (d * 64 + k) * 136 + jj); s += bflo(w) + bfhi(w); }
        CST[(size_t)((chain0 + d) * 34 + cidx) * CSTE + 8192 + k] = s; }
    __syncthreads();
#undef MROW
}

__device__ __forceinline__ void mlstm_state_scan(const Args& a, int gtid, int nthr) {
    const float* __restrict__ CST = (const float*)(a.ws + WS_CST);
    const float* __restrict__ MSC = (const float*)(a.ws + WS_MSC);
    float* __restrict__ CPREV = (float*)(a.ws + WS_CPREV);
    float* __restrict__ MPREV = (float*)(a.ws + WS_MSC + 65536);
    for (int idx = gtid; idx < 32 * CSTE; idx += nthr) {
        const int chain = idx / CSTE, e = idx - chain * CSTE, d = chain & 1;
        float tv[34];
#pragma unroll
        for (int s = 0; s < 34; ++s) { const int cidx = d == 0 ? s : (s < 2 ? 1 - s : 35 - s); tv[s] = CST[(size_t)(chain * 34 + cidx) * CSTE + e]; }
        float val = 0.f, m = 0.f;
#pragma unroll
        for (int s = 0; s < 34; ++s) {
            const int cidx = d == 0 ? s : (s < 2 ? 1 - s : 35 - s);
            const float mloc = MSC[(size_t)(chain * 34 + cidx) * 2], bl = MSC[(size_t)(chain * 34 + cidx) * 2 + 1];
            if (cidx >= 2) { CPREV[(size_t)(chain * 32 + cidx - 2) * CSTE + e] = val; if (e == 0) MPREV[chain * 32 + cidx - 2] = m; }
            const float mn = fmaxf(bl + m, mloc);
            val = __expf(bl + m - mn) * val + __expf(mloc - mn) * tv[s]; m = mn;
        }
    }
}

__device__ __forceinline__ void mlstm_out_item(unsigned char* lds, int item, const Args& a, int tid, int lane, int wave) {
    const bf16_t* P = (const bf16_t*)(a.ws + WS_ACT);
    const float* Gt = (const float*)(a.ws + WS_G);
    const float* CPREV = (const float*)(a.ws + WS_CPREV); const float* MPREV = (const float*)(a.ws + WS_MSC + 65536);
    bf16_t* YA = (bf16_t*)(a.ws + WS_YA);
    bf16_t* Qs = (bf16_t*)lds;
    bf16_t* Ks = (bf16_t*)(lds + 18432);
    bf16_t* VT = (bf16_t*)(lds + 36864);
    bf16_t* Ws = (bf16_t*)(lds + 71680);
    bf16_t* Cs = (bf16_t*)(lds + 106496);
    float* BC = (float*)(lds + 127232);
    float* UU = (float*)(lds + 127232 + 1024);
    float* MM = (float*)(lds + 127232 + 2048);
    float* MP = (float*)(lds + 127232 + 3072);
    const int c = item & 31, bh = item >> 5, h = bh & 7, b = bh >> 3;
    const int chain0 = (b * 8 + h) * 2;
    if (wave < 2) {
        const int d = wave; const float mprev = MPREV[(chain0 + d) * 32 + c];
        const int j0 = d ? 127 - 2 * lane : 2 * lane, j1 = d ? 126 - 2 * lane : 2 * lane + 1;
        const float* g0p = Gt + (size_t)mrow_lat(b, c * 128 + j0) * 32 + h; const float* g1p = Gt + (size_t)mrow_lat(b, c * 128 + j1) * 32 + h;
        const float ig0 = g0p[(2 * d) * 8], fg0 = g0p[(2 * d + 1) * 8], ig1 = g1p[(2 * d) * 8], fg1 = g1p[(2 * d + 1) * 8];
        const float l0 = logsigmoidf_(fg0), l1 = logsigmoidf_(fg1);
        const float s1 = l0 + l1, incl = wave_incl_sum(s1, lane), excl = incl - s1, bc0 = excl + l0, bc1 = excl + s1;
        const float u0 = ig0 - bc0, u1 = ig1 - bc1;
        const float p1 = fmaxf(u0, u1), inclm = wave_incl_max(p1, lane);
        float exclm = __shfl_up(inclm, 1); if (lane == 0) exclm = -INFINITY;
        BC[d * 128 + j0] = bc0; BC[d * 128 + j1] = bc1; UU[d * 128 + j0] = u0; UU[d * 128 + j1] = u1;
        MM[d * 128 + j0] = fmaxf(mprev, fmaxf(exclm, u0)); MM[d * 128 + j1] = fmaxf(mprev, fmaxf(exclm, p1));
        if (lane == 0) MP[d] = mprev;
    }
    {
        const int j = tid >> 2, q4 = tid & 3; const size_t prow = (size_t)mrow_lat(b, c * 128 + j) * DINP;
        const u32x4* qs_ = (const u32x4*)(P + prow + PC_Q + h * 64 + q4 * 16);
        *(u32x4*)(Qs + j * 72 + q4 * 16) = qs_[0]; *(u32x4*)(Qs + j * 72 + q4 * 16 + 8) = qs_[1];
        const u32x4* ks_ = (const u32x4*)(P + prow + PC_K + h * 64 + q4 * 16);
#pragma unroll
        for (int cc = 0; cc < 2; ++cc) { const u32x4 x = ks_[cc]; u32x4 y;
            y.x = pk2(bflo(x.x) * 0.125f, bfhi(x.x) * 0.125f); y.y = pk2(bflo(x.y) * 0.125f, bfhi(x.y) * 0.125f); y.z = pk2(bflo(x.z) * 0.125f, bfhi(x.z) * 0.125f); y.w = pk2(bflo(x.w) * 0.125f, bfhi(x.w) * 0.125f);
            *(u32x4*)(Ks + j * 72 + q4 * 16 + cc * 8) = y; }
        const u32x4* vs = (const u32x4*)(P + prow + PC_V + h * 128 + q4 * 32);
#pragma unroll
        for (int cc = 0; cc < 4; ++cc) { const u32x4 x = vs[cc]; const unsigned xw[4] = {x.x, x.y, x.z, x.w};
#pragma unroll
            for (int i = 0; i < 4; ++i) { VT[(q4 * 32 + cc * 8 + 2 * i) * 136 + j] = (bf16_t)(xw[i] & 0xffffu); VT[(q4 * 32 + cc * 8 + 2 * i + 1) * 136 + j] = (bf16_t)(xw[i] >> 16); } }
    }
    for (int i = tid; i < 540; i += NTHR) ((unsigned*)(Cs + 129 * 72))[i] = 0u;
    __syncthreads();
    const int fr = lane & 15, fq = lane >> 4, trow = 16 * wave + 4 * fq;
    f32x4 S[8];
#pragma unroll
    for (int nt = 0; nt < 8; ++nt) S[nt] = (f32x4){0.f, 0.f, 0.f, 0.f};
#pragma unroll
    for (int ks = 0; ks < 2; ++ks) {
        const bf16x8 A = *(const bf16x8*)(Qs + (16 * wave + fr) * 72 + ks * 32 + fq * 8);
#pragma unroll
        for (int nt = 0; nt < 8; ++nt) { const bf16x8 B = *(const bf16x8*)(Ks + (16 * nt + fr) * 72 + ks * 32 + fq * 8); S[nt] = MFMA16(A, B, S[nt]); }
    }
    f32x4 hsum[8];
#pragma unroll
    for (int nt = 0; nt < 8; ++nt) hsum[nt] = (f32x4){0.f, 0.f, 0.f, 0.f};
#pragma unroll 1
    for (int d = 0; d < 2; ++d) {
        { const f32x4* src = (const f32x4*)(CPREV + (size_t)((chain0 + d) * 32 + c) * CSTE);
          for (int i = tid; i < CSTE / 4; i += NTHR) { const f32x4 x = src[i]; const int e = i * 4, v = e >> 6, k = e & 63;
              *(unsigned long long*)(Cs + v * 72 + k) = (unsigned long long)pk2(x.x, x.y) | ((unsigned long long)pk2(x.z, x.w) << 32); } }
        float Mt[4], den2[4];
#pragma unroll
        for (int i = 0; i < 4; ++i) { Mt[i] = MM[d * 128 + trow + i]; den2[i] = 0.f; }
#pragma unroll
        for (int nt = 0; nt < 8; ++nt) {
            const int s = 16 * nt + fr; const float us = UU[d * 128 + s];
#pragma unroll
            for (int i = 0; i < 4; ++i) { const int t = trow + i; const bool ok = d ? (s >= t) : (s <= t);
                const float wv = ok ? S[nt][i] * __expf(us - Mt[i]) : 0.f; den2[i] += wv; Ws[t * 136 + s] = f2bf(wv); }
        }
#pragma unroll
        for (int i = 0; i < 4; ++i) { float v = den2[i]; v += __shfl_xor(v, 1); v += __shfl_xor(v, 2); v += __shfl_xor(v, 4); v += __shfl_xor(v, 8); den2[i] = v; }
        __syncthreads();
        f32x4 O[9];
#pragma unroll
        for (int nt = 0; nt < 9; ++nt) O[nt] = (f32x4){0.f, 0.f, 0.f, 0.f};
#pragma unroll
        for (int ks = 0; ks < 2; ++ks) {
            const bf16x8 A = *(const bf16x8*)(Qs + (16 * wave + fr) * 72 + ks * 32 + fq * 8);
#pragma unroll
            for (int nt = 0; nt < 9; ++nt) { const bf16x8 B = *(const bf16x8*)(Cs + (16 * nt + fr) * 72 + ks * 32 + fq * 8); O[nt] = MFMA16(A, B, O[nt]); }
        }
        const float mprev = MP[d];
        float si[4], den1[4];
#pragma unroll
        for (int i = 0; i < 4; ++i) { si[i] = __expf(mprev - Mt[i]); den1[i] = __shfl(O[8][i], lane & 48); }
#pragma unroll
        for (int nt = 0; nt < 8; ++nt)
#pragma unroll
            for (int i = 0; i < 4; ++i) O[nt][i] *= si[i];
#pragma unroll
        for (int ks = 0; ks < 4; ++ks) {
            const bf16x8 A = *(const bf16x8*)(Ws + (16 * wave + fr) * 136 + ks * 32 + fq * 8);
#pragma unroll
            for (int nt = 0; nt < 8; ++nt) { const bf16x8 B = *(const bf16x8*)(VT + (16 * nt + fr) * 136 + ks * 32 + fq * 8); O[nt] = MFMA16(A, B, O[nt]); }
        }
#pragma unroll
        for (int i = 0; i < 4; ++i) {
            const float den = si[i] * den1[i] + den2[i];
            const float dn = fmaxf(fabsf(den), __expf(-(BC[d * 128 + trow + i] + Mt[i])));
            const float inv = 1.0f / dn;
#pragma unroll
            for (int nt = 0; nt < 8; ++nt) hsum[nt][i] += O[nt][i] * inv;
        }
        __syncthreads();
    }
    const float* gain = a.in[19] + h * 128;
#pragma unroll
    for (int i = 0; i < 4; ++i) {
        float ss = 0.f;
#pragma unroll
        for (int nt = 0; nt < 8; ++nt) ss += hsum[nt][i] * hsum[nt][i];
        ss += __shfl_xor(ss, 1); ss += __shfl_xor(ss, 2); ss += __shfl_xor(ss, 4); ss += __shfl_xor(ss, 8);
        const float rinv = 1.0f / sqrtf(ss * (1.0f / 128.0f) + EPS);
        const size_t row = (size_t)mrow_lat(b, c * 128 + trow + i);
#pragma unroll
        for (int nt = 0; nt < 8; ++nt) { const int v = 16 * nt + fr;
            const float o = bf2f(P[row * DINP + PC_O + h * 128 + v]);
            YA[row * D + 1024 + h * 128 + v] = f2bf(hsum[nt][i] * rinv * gain[v] * sigmoidf_(o)); }
    }
    __syncthreads();
}

#ifndef PROBE
#define PROBE 0
#endif
#ifndef STAGE
#define STAGE 99
#endif
__global__ void __launch_bounds__(NTHR, 2) mega(Args a) {
    extern __shared__ __attribute__((aligned(16))) unsigned char lds[];
    cg::grid_group grid = cg::this_grid();
    const int tid = threadIdx.x, lane = tid & 63, wave = __builtin_amdgcn_readfirstlane(tid >> 6);
    const int G = gridDim.x, gw = blockIdx.x * 8 + wave, NGW = G * 8;
    unsigned char* ws = a.ws;
    float* mod = (float*)(ws + WS_MOD);
    bf16_t* XN = (bf16_t*)(ws + WS_XN);
    bf16_t* ACT = (bf16_t*)(ws + WS_ACT);
    bf16_t* P = (bf16_t*)(ws + WS_ACT);
    float* X = (float*)(ws + WS_X);
    PG8_LAS unsigned char* ldsl = (PG8_LAS unsigned char*)lds;
    volatile LAS unsigned* MISC = (volatile LAS unsigned*)(ldsl + (LDS_BYTES - 64));
    if (tid < 16) MISC[tid] = 0u;
    __syncthreads();
    const XcdBarrier xbar = xcd_barrier_post((unsigned*)(ws + WS_BAR), MISC + 8);
    if (a.never) grid.sync();
#define GSYNC() xcd_barrier(xbar)

    phase0(a, lds, tid, lane, wave);
    GSYNC();
#if PROBE == 6
    for (int i = 0; i < 10; ++i) GSYNC();
#endif
#if PROBE == 1
    phase0(a, lds, tid, lane, wave);
    GSYNC();
#endif
    norm_mod_rows(a.in[0], a.in[2], MT, a.in[6], mod, 0, XN, gw, NGW, lane);
    GSYNC();
    { pg8::Gemm g{XN, (const bf16_t*)(ws + WS_WUP1), MT, 2 * DFF, D, D}; pg8::StaticOrder S; S.init(MT, 2 * DFF, G, (int)blockIdx.x);
      EpiSwiglu E{ACT, DFF}; pg8::gemm_phase<EpiSwiglu, pg8::StaticOrder, true, true>(ldsl, g, S, E); }
    GSYNC();
#if PROBE == 2
    { pg8::Gemm g{XN, (const bf16_t*)(ws + WS_WUP1), MT, 2 * DFF, D, D}; pg8::StaticOrder S; S.init(MT, 2 * DFF, G, (int)blockIdx.x);
      EpiSwiglu E{ACT, DFF}; pg8::gemm_phase<EpiSwiglu, pg8::StaticOrder, true, true>(ldsl, g, S, E); }
    GSYNC();
#endif
    { pg8::Gemm g{ACT, (const bf16_t*)(ws + WS_WDN1), ML, D, DFF, DFF}; pg8::StaticOrder S; S.init(ML, D, G, (int)blockIdx.x);
      EpiResid E{a.in[0], a.in[2], X, mod, 2 * D, 0.5f, nullptr}; pg8::gemm_phase<EpiResid, pg8::StaticOrder, true, true>(ldsl, g, S, E); }
    { pg8::Gemm g{ACT, (const bf16_t*)(ws + WS_WDN1), MT, D, KSPLIT, DFF}; SplitOrder S; S.init(G, (int)blockIdx.x);
      EpiResid E{a.in[0], a.in[2], X, mod, 2 * D, 0.5f, (float*)(ws + WS_HL)}; pg8::gemm_phase<EpiResid, SplitOrder, true, true>(ldsl, g, S, E); }
    GSYNC();
#if STAGE >= 2
    norm_mod_rows(X, a.in[2], MT, a.in[9], mod, 1, XN, gw, NGW, lane, (const float*)(ws + WS_HL), mod + (size_t)2 * NMOD + 2 * D);
    GSYNC();
    { pg8::Gemm g{XN, (const bf16_t*)(ws + WS_WIN), MT, DINP, D, D}; pg8::StaticOrder S; S.init(MT, DINP, G, (int)blockIdx.x);
      EpiInProj E{P, (float*)(ws + WS_G), a.in[11]}; pg8::gemm_phase<EpiInProj, pg8::StaticOrder, true, true>(ldsl, g, S, E); }
    GSYNC();
    for (int it = blockIdx.x; it < 1088 + 544; it += G) {
        if (it < 1088) lru_local_item(lds, it, a, tid, lane, wave);
        else mlstm_local_item(lds, it - 1088, a, tid, lane, wave);
    }
    GSYNC();
    lru_carry(a, blockIdx.x * NTHR + tid, G * NTHR);
    mlstm_state_scan(a, blockIdx.x * NTHR + tid, G * NTHR);
    GSYNC();
    for (int it = blockIdx.x; it < 512; it += G) mlstm_out_item(lds, it, a, tid, lane, wave);
    lru_combine_rows(a, gw, NGW, lane);
    GSYNC();
#if PROBE == 3
    for (int it = blockIdx.x; it < 1088 + 544; it += G) {
        if (it < 1088) lru_local_item(lds, it, a, tid, lane, wave);
        else mlstm_local_item(lds, it - 1088, a, tid, lane, wave);
    }
    GSYNC();
#endif
#if PROBE == 4
    lru_carry(a, blockIdx.x * NTHR + tid, G * NTHR);
    mlstm_state_scan(a, blockIdx.x * NTHR + tid, G * NTHR);
    GSYNC();
#endif
#if PROBE == 5
    for (int it = blockIdx.x; it < 512; it += G) mlstm_out_item(lds, it, a, tid, lane, wave);
    lru_combine_rows(a, gw, NGW, lane);
    GSYNC();
#endif
    { pg8::Gemm g{(const bf16_t*)(ws + WS_YA), (const bf16_t*)(ws + WS_WOUT), ML, D, D, D}; pg8::StaticOrder S; S.init(ML, D, G, (int)blockIdx.x);
      EpiResid E{X, X, X, mod, 5 * D, 1.0f, nullptr}; pg8::gemm_phase<EpiResid, pg8::StaticOrder, true, true>(ldsl, g, S, E); }
    GSYNC();
#endif
#if STAGE >= 3
    norm_mod_rows(X, X, ML, a.in[21], mod, 2, XN, gw, NGW, lane);
    GSYNC();
    { pg8::Gemm g{XN, (const bf16_t*)(ws + WS_WUP2), ML, 2 * DFF, D, D}; pg8::StaticOrder S; S.init(ML, 2 * DFF, G, (int)blockIdx.x);
      EpiSwiglu E{ACT, DFF}; pg8::gemm_phase<EpiSwiglu, pg8::StaticOrder, true, true>(ldsl, g, S, E); }
    GSYNC();
    { pg8::Gemm g{ACT, (const bf16_t*)(ws + WS_WDN2), ML, D, DFF, DFF}; pg8::StaticOrder S; S.init(ML, D, G, (int)blockIdx.x);
      EpiResid E{X, X, X, mod, 8 * D, 0.5f, nullptr}; pg8::gemm_phase<EpiResid, pg8::StaticOrder, true, true>(ldsl, g, S, E); }
    GSYNC();
#endif
    final_norm_rows(X, a.in[24], a.out, gw, NGW, lane);
}

extern "C" void kernel_launch(void* const* d_in, const int* in_sizes, int n_in, void* d_out, int out_size, void* d_ws, size_t ws_size, hipStream_t stream) {
    static int grid = 0;
    if (grid == 0) {
        if (n_in != 25 || out_size != ML * D || ws_size < WS_END) { fprintf(stderr, "kernel_launch: unexpected shapes (n_in %d out %d ws %zu)\n", n_in, out_size, ws_size); grid = -1; return; }
        int dev = 0, cus = 0, per_cu = 0;
        hipGetDevice(&dev);
        hipDeviceGetAttribute(&cus, hipDeviceAttributeMultiprocessorCount, dev);
        hipFuncSetAttribute((const void*)mega, hipFuncAttributeMaxDynamicSharedMemorySize, LDS_BYTES);
        hipOccupancyMaxActiveBlocksPerMultiprocessor(&per_cu, (const void*)mega, NTHR, LDS_BYTES);
        if (per_cu < 1) fprintf(stderr, "kernel_launch: occupancy query says %d blocks per CU\n", per_cu);
        (void)hipGetLastError();
        grid = cus;
    }
    if (grid < 0) return;
    if (hipMemsetAsync((char*)d_ws + WS_BAR, 0, 16384, stream) != hipSuccess) { fprintf(stderr, "kernel_launch: memset of the barrier words failed\n"); return; }
    Args a{};
    for (int i = 0; i < 25; ++i) a.in[i] = (const float*)d_in[i];
    a.out = (float*)d_out; a.ws = (unsigned char*)d_ws;
    void* args[] = {&a};
    hipError_t e = hipLaunchCooperativeKernel((const void*)mega, dim3(grid), dim3(NTHR), args, LDS_BYTES, stream);
    if (e != hipSuccess) fprintf(stderr, "cooperative launch failed: %s (grid %d)\n", hipGetErrorString(e), grid);
}
```

```cpp
#include <hip/hip_runtime.h>
#include <hip/hip_cooperative_groups.h>
#include <cstdio>
#include <cstdint>
namespace cg = cooperative_groups;
#define STAGE 99
#define PROBE 0
namespace pg8 {
#define PG8_LAS __attribute__((address_space(3)))
typedef unsigned short bf16_t;
typedef short bf16x8 __attribute__((ext_vector_type(8)));
typedef float f32x4 __attribute__((ext_vector_type(4)));
typedef unsigned u32x4 __attribute__((ext_vector_type(4)));
constexpr int BM = 256, BK = 64, HALF = 128, HTB = HALF * BK * 2  , STAGE_BYTES = 8 * HTB, NXCD = 8, WGM = 8;

__host__ __device__ __forceinline__ int lds_byte(int r, int c) { const int st = (r >> 4) * 2 + (c >> 5), rr = r & 15, cc = c & 31, ob = rr * 64 + cc * 2; return st * 1024 + (ob ^ (((ob >> 9) & 1) << 5)); }
__host__ __device__ __forceinline__ void stage_rc(int b, int& R, int& C) { const int st = b / 1024, sb = b % 1024, swz = sb ^ (((sb >> 9) & 1) << 5); R = (st >> 1) * 16 + swz / 64; C = (st & 1) * 32 + (swz % 64) / 2; }
__host__ __device__ __forceinline__ int perm32(int rho) { const int n = rho >> 4, i = rho & 15; return 8 * (i >> 2) + 4 * n + (i & 3); }

struct Unit { int pm, pn, k0; };
struct Gemm { const bf16_t* A; const bf16_t* Bt; int M, N, K, ld; };

struct StaticOrder {
    int nM, nN, nwg, G, c;
    __host__ __device__ void init(int M, int N, int G_, int c_) { nM = M / BM; nN = N / BM; nwg = nM * nN; G = G_; c = c_; }
    __host__ __device__ bool next(int i, Unit& u) const {
        const long L = (long)i * G + c; if (L >= nwg) return false;
        int wgid = (int)L; { const int q = nwg / NXCD, r = nwg % NXCD, xcd = wgid % NXCD, off = wgid / NXCD; wgid = (xcd < r ? xcd * (q + 1) : r * (q + 1) + (xcd - r) * q) + off; }
        const int nig = WGM * nN, gid = wgid / nig, fm = gid * WGM, gsz = (nM - fm) < WGM ? (nM - fm) : WGM;
        u.pm = fm + ((wgid % nig) % gsz); u.pn = (wgid % nig) / gsz; u.k0 = 0; return true;
    }
    __device__ __forceinline__ void a_ready(const Unit&) const {}
    __device__ __forceinline__ void done(const Unit&) const {}
};

__device__ __forceinline__ unsigned cvt_pk_bf16(float lo, float hi) { unsigned r; asm volatile("v_cvt_pk_bf16_f32 %0, %1, %2" : "=v"(r) : "v"(lo), "v"(hi)); return r; }
typedef float f32x2 __attribute__((ext_vector_type(2)));
__device__ __forceinline__ f32x2 gelu_pk(f32x2 v) {
    const f32x2 av = __builtin_elementwise_abs(v), d = av * 0.2316418882f + 1.0f;
    f32x2 t; t.x = __builtin_amdgcn_rcpf(d.x); t.y = __builtin_amdgcn_rcpf(d.y);
    f32x2 q = t * 0.5307027145f + (-0.7265760135f); q = q * t + 0.7107068705f; q = q * t + (-0.142248368f); q = q * t + 0.127414796f; q = q * t;
    const f32x2 s = (v * v) * (-0.72134752044f);
    f32x2 e; e.x = __builtin_amdgcn_exp2f(s.x); e.y = __builtin_amdgcn_exp2f(s.y);
    const f32x2 m = v * (q * e), r = v - m;
    f32x2 o; o.x = v.x < 0.f ? m.x : r.x; o.y = v.y < 0.f ? m.y : r.y; return o;
}

template <class Epi, class Sched, bool ALIGN_EPI = false, bool SP2 = false>
__device__ __forceinline__ void gemm_phase(PG8_LAS unsigned char* lds, const Gemm g, const Sched& S, const Epi& E) {
    const int tid = threadIdx.x, wid = __builtin_amdgcn_readfirstlane(tid >> 6), lane = tid & 63, wr = wid >> 2, wc = wid & 3, fr = lane & 15, fq = lane >> 4;
    const int K = g.ld, nt = g.K / BK;
    unsigned voffA[2], voffB[2];
#pragma unroll
    for (int i = 0; i < 2; ++i) { int R, C; stage_rc(tid * 16 + i * 8192, R, C); const int Rb = Epi::PERM ? ((R & ~31) + perm32(R & 31)) : R;
        voffA[i] = (unsigned)(R * K + C) * 2u; voffB[i] = (unsigned)(Rb * K + C) * 2u; }
    const size_t kstep = (size_t)(BK * 2);
    const size_t hstep = (size_t)HALF * K * 2;
    const size_t tstep = 2 * hstep;
    const unsigned ldsw = (unsigned)wid * 1024u;
    const int aoff = lds_byte(wr * 64 + fr, fq * 8), boff = lds_byte(wc * 32 + fr, fq * 8);
#define PG8_SA(b, h) (((b) * 2 + (h)) * HTB)
#define PG8_SB(b, h) ((4 + (b) * 2 + (h)) * HTB)
#define PG8_STAGE(bufoff, gbase, voff) do { _Pragma("unroll") for (int _i = 0; _i < 2; ++_i) \
        __builtin_amdgcn_global_load_lds((const unsigned*)((const char*)(gbase) + (voff)[_i]), (PG8_LAS unsigned*)(lds + (bufoff) + ldsw + _i * 8192), 16, 0, 0); } while (0)
#define PG8_LDA(dst, b, h) do { _Pragma("unroll") for (int m = 0; m < 4; ++m) _Pragma("unroll") for (int k = 0; k < 2; ++k) dst[m][k] = *(const PG8_LAS bf16x8*)(lds + PG8_SA(b, h) + aoff + m * 2048 + k * 1024); } while (0)
#define PG8_LDB(dst, b, h) do { _Pragma("unroll") for (int n = 0; n < 2; ++n) _Pragma("unroll") for (int k = 0; k < 2; ++k) dst[n][k] = *(const PG8_LAS bf16x8*)(lds + PG8_SB(b, h) + boff + n * 2048 + k * 1024); } while (0)
#define PG8_MMA(ai, bj, At, Bt) do { __builtin_amdgcn_s_setprio(1); _Pragma("unroll") for (int m = 0; m < 4; ++m) _Pragma("unroll") for (int n = 0; n < 2; ++n) _Pragma("unroll") for (int k = 0; k < 2; ++k) \
        acc[ai][bj][m][n] = __builtin_amdgcn_mfma_f32_16x16x32_bf16(Bt[n][k], At[m][k], acc[ai][bj][m][n], 0, 0, 0); __builtin_amdgcn_s_setprio(0); } while (0)
#define PG8_WAIT_V(n) asm volatile("s_waitcnt vmcnt(" #n ")" ::: "memory")
#define PG8_WAIT_L(n) asm volatile("s_waitcnt lgkmcnt(" #n ")" ::: "memory")
#define PG8_BAR __builtin_amdgcn_s_barrier()
#define PG8_SCHED __builtin_amdgcn_sched_barrier(0)
    Unit cur, nxt; int ui = 0;
    if (!S.next(0, cur)) return;
    f32x4 acc[2][2][4][2];
#pragma unroll
    for (int a = 0; a < 2; ++a)
#pragma unroll
        for (int b = 0; b < 2; ++b)
#pragma unroll
            for (int m = 0; m < 4; ++m)
#pragma unroll
                for (int n = 0; n < 2; ++n) acc[a][b][m][n] = (f32x4){0.f, 0.f, 0.f, 0.f};
    bf16x8 At[4][2], B0[2][2], B1[2][2];
    const char* cA = (const char*)g.A + (size_t)cur.pm * tstep + (size_t)cur.k0 * 2; const char* cB = (const char*)g.Bt + (size_t)cur.pn * tstep + (size_t)cur.k0 * 2;
    S.a_ready(cur);
    if constexpr (SP2) {
        PG8_STAGE(PG8_SB(0, 0), cB, voffB); PG8_STAGE(PG8_SB(0, 1), cB + hstep, voffB); PG8_STAGE(PG8_SA(0, 0), cA, voffA); PG8_STAGE(PG8_SA(0, 1), cA + hstep, voffA);
        if (wr == 1) PG8_BAR;
        PG8_WAIT_V(2); PG8_BAR;
        PG8_STAGE(PG8_SB(1, 0), cB + kstep, voffB); PG8_STAGE(PG8_SA(1, 0), cA + kstep, voffA); PG8_STAGE(PG8_SB(1, 1), cB + hstep + kstep, voffB);
        PG8_WAIT_V(6); PG8_BAR;
    } else {
        PG8_STAGE(PG8_SB(0, 0), cB, voffB); PG8_STAGE(PG8_SA(0, 0), cA, voffA); PG8_STAGE(PG8_SB(0, 1), cB + hstep, voffB); PG8_STAGE(PG8_SA(0, 1), cA + hstep, voffA);
        if (wr == 1) PG8_BAR;
        PG8_WAIT_V(4); PG8_BAR;
        PG8_STAGE(PG8_SB(1, 0), cB + kstep, voffB); PG8_STAGE(PG8_SA(1, 0), cA + kstep, voffA); PG8_STAGE(PG8_SB(1, 1), cB + hstep + kstep, voffB);
        PG8_WAIT_V(6); PG8_BAR;
    }
    for (;;) {
        const bool has_next = S.next(ui + 1, nxt);
        const char* nA = has_next ? (const char*)g.A + (size_t)nxt.pm * tstep + (size_t)nxt.k0 * 2 : cA; const char* nB = has_next ? (const char*)g.Bt + (size_t)nxt.pn * tstep + (size_t)nxt.k0 * 2 : cB;
        for (int t = 0; t < nt; t += 2) {
            const bool last = (t == nt - 2);
            const char* a1 = cA + (size_t)(t + 1) * kstep;
            const char* a2 = last ? nA : cA + (size_t)(t + 2) * kstep; const char* b2 = last ? nB : cB + (size_t)(t + 2) * kstep;
            const char* a3 = a2 + kstep; const char* b3 = b2 + kstep;
            if (last && has_next) S.a_ready(nxt);
            if constexpr (SP2) {
            PG8_LDB(B0, 0, 0); PG8_LDB(B1, 0, 1); PG8_SCHED; PG8_LDA(At, 0, 0); PG8_STAGE(PG8_SA(1, 1), a1 + hstep, voffA);
            PG8_WAIT_V(8); PG8_WAIT_L(0); PG8_BAR; PG8_MMA(0, 0, At, B0); PG8_MMA(0, 1, At, B1); PG8_BAR; PG8_SCHED;
            PG8_LDA(At, 0, 1); PG8_STAGE(PG8_SB(0, 0), b2, voffB); PG8_STAGE(PG8_SB(0, 1), b2 + hstep, voffB); PG8_STAGE(PG8_SA(0, 0), a2, voffA);
            PG8_WAIT_V(8); PG8_WAIT_L(0); PG8_BAR; PG8_MMA(1, 0, At, B0); PG8_MMA(1, 1, At, B1); PG8_BAR; PG8_SCHED;
            PG8_LDB(B0, 1, 0); PG8_LDB(B1, 1, 1); PG8_SCHED; PG8_LDA(At, 1, 0); PG8_STAGE(PG8_SA(0, 1), a2 + hstep, voffA);
            PG8_WAIT_V(8); PG8_WAIT_L(0); PG8_BAR; PG8_MMA(0, 0, At, B0); PG8_MMA(0, 1, At, B1); PG8_BAR; PG8_SCHED;
            PG8_LDA(At, 1, 1); PG8_STAGE(PG8_SB(1, 0), b3, voffB); PG8_STAGE(PG8_SB(1, 1), b3 + hstep, voffB); PG8_STAGE(PG8_SA(1, 0), a3, voffA);
            PG8_WAIT_V(8); PG8_WAIT_L(0); PG8_BAR; PG8_MMA(1, 0, At, B0); PG8_MMA(1, 1, At, B1); PG8_BAR; PG8_SCHED;
            } else {
            PG8_LDB(B0, 0, 0); PG8_SCHED; PG8_LDA(At, 0, 0); PG8_STAGE(PG8_SA(1, 1), a1 + hstep, voffA);
            PG8_WAIT_L(8); PG8_BAR; PG8_WAIT_L(0); PG8_MMA(0, 0, At, B0); PG8_BAR; PG8_SCHED;
            PG8_LDB(B1, 0, 1); PG8_STAGE(PG8_SB(0, 0), b2, voffB);
            PG8_BAR; PG8_WAIT_L(0); PG8_MMA(0, 1, At, B1); PG8_BAR;
            PG8_LDA(At, 0, 1); PG8_STAGE(PG8_SA(0, 0), a2, voffA);
            PG8_BAR; PG8_WAIT_L(0); PG8_MMA(1, 0, At, B0); PG8_BAR; PG8_SCHED;
            PG8_STAGE(PG8_SB(0, 1), b2 + hstep, voffB);
            PG8_WAIT_V(6); PG8_BAR; PG8_MMA(1, 1, At, B1); PG8_BAR;
            PG8_LDB(B0, 1, 0); PG8_SCHED; PG8_LDA(At, 1, 0); PG8_STAGE(PG8_SA(0, 1), a2 + hstep, voffA);
            PG8_WAIT_L(8); PG8_BAR; PG8_WAIT_L(0); PG8_MMA(0, 0, At, B0); PG8_BAR; PG8_SCHED;
            PG8_LDB(B1, 1, 1); PG8_STAGE(PG8_SB(1, 0), b3, voffB);
            PG8_BAR; PG8_WAIT_L(0); PG8_MMA(0, 1, At, B1); PG8_BAR;
            PG8_LDA(At, 1, 1); PG8_STAGE(PG8_SA(1, 0), a3, voffA);
            PG8_BAR; PG8_WAIT_L(0); PG8_MMA(1, 0, At, B0); PG8_BAR; PG8_SCHED;
            PG8_STAGE(PG8_SB(1, 1), b3 + hstep, voffB);
            PG8_WAIT_V(6); PG8_BAR; PG8_MMA(1, 1, At, B1); PG8_BAR;
            }
        }
        if constexpr (ALIGN_EPI) { if (wr == 0) PG8_BAR; }
        if constexpr (!Epi::AFTER_DRAIN) { E(acc, cur, wr, wc, fr, fq); S.done(cur); }
        if (!has_next) break;
#pragma unroll
        for (int a = 0; a < 2; ++a)
#pragma unroll
            for (int b = 0; b < 2; ++b)
#pragma unroll
                for (int m = 0; m < 4; ++m)
#pragma unroll
                    for (int n = 0; n < 2; ++n) acc[a][b][m][n] = (f32x4){0.f, 0.f, 0.f, 0.f};
        cur = nxt; cA = nA; cB = nB; ++ui;
        if constexpr (ALIGN_EPI) { if (wr == 1) PG8_BAR; }
    }
    PG8_WAIT_V(0);
    if constexpr (!ALIGN_EPI) { if (wr == 0) PG8_BAR; }
    PG8_BAR;
    if constexpr (Epi::AFTER_DRAIN) { E.fused(acc, cur, wr, wc, fr, fq, lds, wid, lane); S.done(cur); }
#undef PG8_SA
#undef PG8_SB
#undef PG8_STAGE
#undef PG8_LDA
#undef PG8_LDB
#undef PG8_MMA
#undef PG8_WAIT_V
#undef PG8_WAIT_L
#undef PG8_BAR
#undef PG8_SCHED
}
}
#define LAS __attribute__((address_space(3)))
#define XB_TMO      128
#define XB_XCNT(j)  (256  + 64 * (j))
#define XB_XSUB(j)  (1280 + 64 * (j))
#define XB_XGEN(j)  (2304 + 64 * (j))
#define XB_TOP      3328
#define XB_TOPGEN   3392
#define XCD_BAR_WORDS 3456
#define XB_SPIN_CAP (1u << 18)

__device__ __forceinline__ unsigned xb_ld(unsigned* p)              { return __hip_atomic_load(p, __ATOMIC_RELAXED, __HIP_MEMORY_SCOPE_AGENT); }
__device__ __forceinline__ unsigned xb_add(unsigned* p, unsigned v) { return __hip_atomic_fetch_add(p, v, __ATOMIC_RELAXED, __HIP_MEMORY_SCOPE_AGENT); }
__device__ __forceinline__ unsigned xb_xcc_id() { return (unsigned)__builtin_amdgcn_s_getreg((3 << 11) | 20) & 0xFu; }
#define XB_SPIN(cond, bar) do { unsigned _sp = 0; while (cond) { __builtin_amdgcn_s_sleep(1); \
    if ((++_sp & 255u) == 0u) { if (xb_ld(&(bar)[XB_TMO])) break; if (_sp > XB_SPIN_CAP) { atomicAdd(&(bar)[XB_TMO], 1u); break; } } } } while (0)

struct XcdBarrier {
    unsigned* bar; unsigned x;
    volatile LAS unsigned* st;
};

__device__ __forceinline__ XcdBarrier xcd_barrier_post(unsigned* bar, volatile LAS unsigned* st) {
    XcdBarrier b; b.bar = bar; b.x = xb_xcc_id(); b.st = st;
    if (threadIdx.x == 0) (void)xb_add(&bar[XB_XCNT(b.x)], 1u);
    return b;
}
__device__ __forceinline__ void xcd_barrier_complete(unsigned* bar, unsigned x, unsigned& nloc, unsigned& nx) {
    const unsigned G = gridDim.x * gridDim.y * gridDim.z;
    unsigned sum, cnt, mine, sp = 0u;
    for (;;) {
        sum = 0u; cnt = 0u; mine = 0u;
#pragma unroll
        for (unsigned j = 0; j < 16; ++j) { const unsigned c = xb_ld(&bar[XB_XCNT(j)]); sum += c; cnt += (c > 0u) ? 1u : 0u; mine = (j == x) ? c : mine; }
        if (sum == G) break;
        __builtin_amdgcn_s_sleep(1);
        if ((++sp & 255u) == 0u) { if (xb_ld(&bar[XB_TMO])) break; if (sp > XB_SPIN_CAP) { atomicAdd(&bar[XB_TMO], 1u); break; } }
    }
    nloc = mine > 0u ? mine : 1u; nx = cnt > 0u ? cnt : 1u;
}

__device__ __forceinline__ void xcd_barrier(const XcdBarrier& b) {
    asm volatile("s_waitcnt vmcnt(0)" ::: "memory");
    __syncthreads();
    if (threadIdx.x == 0) {
        unsigned* bar = b.bar;
        __builtin_amdgcn_s_waitcnt(0);
        unsigned nloc = b.st[0], nx = b.st[1];
        if (nloc == 0u) { xcd_barrier_complete(bar, b.x, nloc, nx); b.st[0] = nloc; b.st[1] = nx; }
        const unsigned old = xb_add(&bar[XB_XSUB(b.x)], 1u);
        const unsigned gen = old / nloc;
        if (old + 1u == (gen + 1u) * nloc) {
            __builtin_amdgcn_fence(__ATOMIC_RELEASE, "agent");
            asm volatile("s_waitcnt vmcnt(0)" ::: "memory");
            const unsigned og = xb_add(&bar[XB_TOP], 1u);
            const unsigned tg = og / nx;
            if (og + 1u == (tg + 1u) * nx) xb_add(&bar[XB_TOPGEN], 1u);
            else XB_SPIN(xb_ld(&bar[XB_TOPGEN]) == tg, bar);
            __builtin_amdgcn_fence(__ATOMIC_ACQUIRE, "agent");
            xb_add(&bar[XB_XGEN(b.x)], 1u);
            asm volatile("s_waitcnt vmcnt(0)" ::: "memory");
        } else {
            XB_SPIN(xb_ld(&bar[XB_XGEN(b.x)]) == gen, bar);
            __builtin_amdgcn_fence(__ATOMIC_ACQUIRE, "agent");
            asm volatile("s_waitcnt vmcnt(0)" ::: "memory");
        }
    }
    __syncthreads();
}
using pg8::bf16_t; using pg8::bf16x8; using pg8::f32x4; using pg8::u32x4;

constexpr int NTHR = 512, LDS_BYTES = 147456;
constexpr int D = 2048, SEQ = 4096, BATCH = 2, CTXL = 256, DFF = 5632, DIN = 5152, DINP = 5376;
constexpr int ML = BATCH * SEQ, MC = BATCH * CTXL, MT = ML + MC;
constexpr int NMOD = 9 * D;
constexpr float EPS = 1e-6f;
constexpr int PC_LX = 0, PC_LG = 1024, PC_Q = 2048, PC_K = 2560, PC_V = 3072, PC_O = 4096, PC_GT = 5120;
constexpr size_t MiB = 1u << 20;
constexpr size_t WS_MOD = 0, WS_WG = 1 * MiB, WS_WUP1 = 2 * MiB, WS_WDN1 = 46 * MiB, WS_WIN = 68 * MiB, WS_WOUT = 89 * MiB, WS_WUP2 = 97 * MiB, WS_WDN2 = 141 * MiB,
    WS_XN = 163 * MiB, WS_ACT = 197 * MiB  , WS_X = 291 * MiB, WS_G = 359 * MiB, WS_HL = 361 * MiB, WS_AC = 393 * MiB,
    WS_CSUM = 425 * MiB, WS_CARRY = 428 * MiB, WS_CST = 429 * MiB, WS_MSC = 464 * MiB, WS_YA = 465 * MiB, WS_CPREV = 497 * MiB, WS_END = 530 * MiB;
constexpr int CSTE = 8256;

struct Args { const float* in[25]; float* out; unsigned char* ws; int never, pad; };
constexpr size_t WS_BAR = WS_MOD + 512 * 1024;

__device__ __forceinline__ unsigned pk2(float lo, float hi) { return pg8::cvt_pk_bf16(lo, hi); }
__device__ __forceinline__ unsigned short f2bf(float f) { return (unsigned short)(pg8::cvt_pk_bf16(f, 0.f) & 0xffffu); }
__device__ __forceinline__ float bflo(unsigned w) { return __uint_as_float(w << 16); }
__device__ __forceinline__ float bfhi(unsigned w) { return __uint_as_float(w & 0xffff0000u); }
__device__ __forceinline__ float bf2f(unsigned short h) { return __uint_as_float((unsigned)h << 16); }
__device__ __forceinline__ float sigmoidf_(float x) { return __builtin_amdgcn_rcpf(1.0f + __expf(-x)); }
__device__ __forceinline__ float siluf_(float x) { return x * __builtin_amdgcn_rcpf(1.0f + __expf(-x)); }
__device__ __forceinline__ float logsigmoidf_(float x) { return fminf(x, 0.f) - log1pf(__expf(-fabsf(x))); }
__device__ __forceinline__ float gelu_tanhf_(float x) { const float u2 = 1.5957691216057308f * (x + 0.044715f * x * x * x); return x * __builtin_amdgcn_rcpf(1.0f + __expf(-u2)); }
__device__ __forceinline__ float neg_expm1f_(float x) {
    const float p = -x * (1.0f + x * 0.5f * (1.0f + x * (1.0f / 3.0f) * (1.0f + x * 0.25f * (1.0f + x * 0.2f * (1.0f + x * (1.0f / 6.0f))))));
    return x > -0.3f ? p : 1.0f - __expf(x); }
__device__ __forceinline__ float wave_sum(float v) {
#pragma unroll
    for (int o = 1; o < 64; o <<= 1) v += __shfl_xor(v, o);
    return v;
}
__device__ __forceinline__ float wave_max(float v) {
#pragma unroll
    for (int o = 1; o < 64; o <<= 1) v = fmaxf(v, __shfl_xor(v, o));
    return v;
}
__device__ __forceinline__ float wave_incl_sum(float v, int lane) {
#pragma unroll
    for (int o = 1; o < 64; o <<= 1) { const float t = __shfl_up(v, o); if (lane >= o) v += t; }
    return v;
}
__device__ __forceinline__ float wave_incl_max(float v, int lane) {
#pragma unroll
    for (int o = 1; o < 64; o <<= 1) { const float t = __shfl_up(v, o); if (lane >= o) v = fmaxf(v, t); }
    return v;
}
__device__ __forceinline__ bf16x8 pack8(const float* p) {
    const f32x4 a = *(const f32x4*)p, b = *(const f32x4*)(p + 4);
    u32x4 w; w.x = pk2(a.x, a.y); w.y = pk2(a.z, a.w); w.z = pk2(b.x, b.y); w.w = pk2(b.z, b.w);
    return __builtin_bit_cast(bf16x8, w);
}
#define MFMA16(a, b, c) __builtin_amdgcn_mfma_f32_16x16x32_bf16((a), (b), (c), 0, 0, 0)

struct EpiSwiglu {
    static constexpr bool PERM = true, AFTER_DRAIN = false;
    bf16_t* O; int ldc;
    __device__ __forceinline__ void operator()(const f32x4 (&acc)[2][2][4][2], const pg8::Unit& u, int wr, int wc, int fr, int fq) const {
        const int row0 = u.pm * 256 + wr * 64 + fr, col0 = u.pn * 128 + wc * 32 + 8 * fq;
#pragma unroll
        for (int ai = 0; ai < 2; ++ai)
#pragma unroll
            for (int m = 0; m < 4; ++m) {
                bf16_t* rowp = O + (size_t)(row0 + ai * 128 + m * 16) * ldc + col0;
                const f32x4 g0 = acc[ai][0][m][0], g1 = acc[ai][0][m][1], u0 = acc[ai][1][m][0], u1 = acc[ai][1][m][1];
                u32x4 w;
                w.x = pk2(siluf_(g0[0]) * u0[0], siluf_(g0[1]) * u0[1]); w.y = pk2(siluf_(g0[2]) * u0[2], siluf_(g0[3]) * u0[3]);
                w.z = pk2(siluf_(g1[0]) * u1[0], siluf_(g1[1]) * u1[1]); w.w = pk2(siluf_(g1[2]) * u1[2], siluf_(g1[3]) * u1[3]);
                *(u32x4*)rowp = w;
            }
    }
};
struct EpiResid {
    static constexpr bool PERM = false, AFTER_DRAIN = false;
    const float* baseL; const float* baseC; float* out; const float* mod; int goff; float scale; float* part;
    __device__ __forceinline__ void operator()(const f32x4 (&acc)[2][2][4][2], const pg8::Unit& u, int wr, int wc, int fr, int fq) const {
        const int rowt = u.pm * 256; const int mr = rowt < ML ? (rowt >> 12) : 2;
        const float* bp = rowt < ML ? baseL : baseC - (size_t)ML * D;
        const float* gp = mod + (size_t)mr * NMOD + goff;
        const int col0 = u.pn * 256 + wc * 32 + 4 * fq;
        const bool isp = part != nullptr;
        float* op = isp ? part + (size_t)(u.k0 >> 9) * ((size_t)MC * D) - (size_t)ML * D : out;
#pragma unroll
        for (int bj = 0; bj < 2; ++bj)
#pragma unroll
            for (int n = 0; n < 2; ++n) {
                const int c = col0 + bj * 128 + n * 16;
                f32x4 gv = *(const f32x4*)(gp + c) * scale;
                if (isp) gv = (f32x4){1.f, 1.f, 1.f, 1.f};
#pragma unroll
                for (int ai = 0; ai < 2; ++ai)
#pragma unroll
                    for (int m = 0; m < 4; ++m) {
                        const size_t off = (size_t)(rowt + ai * 128 + wr * 64 + m * 16 + fr) * D + c;
                        f32x4 bs = {0.f, 0.f, 0.f, 0.f};
                        if (!isp) bs = *(const f32x4*)(bp + off);
                        *(f32x4*)(op + off) = bs + gv * acc[ai][bj][m][n];
                    }
                asm volatile("" ::: "memory");
            }
    }
};
struct EpiInProj {
    static constexpr bool PERM = true, AFTER_DRAIN = false;
    bf16_t* P; float* G; const float* bm;
    __device__ __forceinline__ void operator()(const f32x4 (&acc)[2][2][4][2], const pg8::Unit& u, int wr, int wc, int fr, int fq) const {
        const int row0 = u.pm * 256 + wr * 64 + fr, col0 = u.pn * 256 + wc * 32 + 8 * fq;
        const bool gates = (u.pn == PC_GT / 256) && (wc == 0);
#pragma unroll
        for (int ai = 0; ai < 2; ++ai)
#pragma unroll
            for (int m = 0; m < 4; ++m) {
                const int row = row0 + ai * 128 + m * 16;
                bf16_t* rowp = P + (size_t)row * DINP + col0;
#pragma unroll
                for (int bj = 0; bj < 2; ++bj) {
                    const f32x4 v0 = acc[ai][bj][m][0], v1 = acc[ai][bj][m][1];
                    u32x4 w; w.x = pk2(v0[0], v0[1]); w.y = pk2(v0[2], v0[3]); w.z = pk2(v1[0], v1[1]); w.w = pk2(v1[2], v1[3]);
                    *(u32x4*)(rowp + bj * 128) = w;
                }
                if (gates) {
                    const f32x4 b0 = *(const f32x4*)(bm + 8 * fq), b1 = *(const f32x4*)(bm + 8 * fq + 4);
                    *(f32x4*)(G + (size_t)row * 32 + 8 * fq) = acc[ai][0][m][0] + b0;
                    *(f32x4*)(G + (size_t)row * 32 + 8 * fq + 4) = acc[ai][0][m][1] + b1;
                }
            }
    }
};

struct EpiPartial {
    static constexpr bool PERM = false, AFTER_DRAIN = false;
    float* part;
    __device__ __forceinline__ void operator()(const f32x4 (&acc)[2][2][4][2], const pg8::Unit& u, int wr, int wc, int fr, int fq) const {
        float* base = part + (size_t)(u.k0 >> 9) * ((size_t)MC * D) + (size_t)(u.pm * 256 - ML) * D;
        const int col0 = u.pn * 256 + wc * 32 + 4 * fq;
#pragma unroll
        for (int bj = 0; bj < 2; ++bj)
#pragma unroll
            for (int n = 0; n < 2; ++n) {
#pragma unroll
                for (int ai = 0; ai < 2; ++ai)
#pragma unroll
                    for (int m = 0; m < 4; ++m) *(f32x4*)(base + (size_t)(ai * 128 + wr * 64 + m * 16 + fr) * D + col0 + bj * 128 + n * 16) = acc[ai][bj][m][n];
                asm volatile("" ::: "memory");
            }
    }
};
constexpr int NSPLIT = 11, KSPLIT = DFF / NSPLIT;
struct SplitOrder {
    int G, c;
    __device__ void init(int G_, int c_) { G = G_; c = c_; }
    __device__ bool next(int i, pg8::Unit& u) const { const int L = i * G + c; if (L >= 16 * NSPLIT) return false; const int sp = L % NSPLIT, t = L / NSPLIT; u.pm = ML / 256 + (t >> 3); u.pn = t & 7; u.k0 = sp * KSPLIT; return true; }
    __device__ __forceinline__ void a_ready(const pg8::Unit&) const {}
    __device__ __forceinline__ void done(const pg8::Unit&) const {}
};

__device__ __forceinline__ void transpose_item(const float* __restrict__ W, int K, int N, bf16_t* __restrict__ WT, int k0, int n0, int drow0, float* scr, int lane) {
#pragma unroll 8
    for (int i = 0; i < 32; ++i) { const int kk = 2 * i + (lane >> 5); scr[kk * 33 + (lane & 31)] = W[(size_t)(k0 + kk) * N + n0 + (lane & 31)]; }
    __builtin_amdgcn_s_waitcnt(0); asm volatile("" ::: "memory");
    const int c = lane & 7;
#pragma unroll
    for (int j = 0; j < 4; ++j) { const int n = (lane >> 3) + 8 * j; const float* s = scr + (8 * c) * 33 + n;
        u32x4 o; o.x = pk2(s[0 * 33], s[1 * 33]); o.y = pk2(s[2 * 33], s[3 * 33]); o.z = pk2(s[4 * 33], s[5 * 33]); o.w = pk2(s[6 * 33], s[7 * 33]);
        *(u32x4*)(WT + (size_t)(drow0 + n) * K + k0 + 8 * c) = o; }
    __builtin_amdgcn_s_waitcnt(0); asm volatile("" ::: "memory");
}
__device__ __forceinline__ int swiglu_row(int n0) {
    return n0 < DFF ? 256 * (n0 >> 7) + (n0 & 127) : 256 * ((n0 - DFF) >> 7) + 128 + ((n0 - DFF) & 127);
}
constexpr int T_UP = 32 * 352, T_DN = 88 * 64, T_IN = 32 * 161, T_OUT = 32 * 64, T_G = 256;
constexpr int T_ALL = 2 * T_UP + 2 * T_DN + T_IN + T_OUT + T_G;
__device__ __forceinline__ void p0_item(const Args& a, int it, float* scr, int lane) {
    unsigned char* ws = a.ws;
    if (it < 2 * T_UP) { const int w = it >= T_UP; const int r = it - w * T_UP; const int kb = r / 352, nb = r % 352;
        transpose_item(a.in[w ? 22 : 7], D, 2 * DFF, (bf16_t*)(ws + (w ? WS_WUP2 : WS_WUP1)), 64 * kb, 32 * nb, swiglu_row(32 * nb), scr, lane); return; }
    it -= 2 * T_UP;
    if (it < 2 * T_DN) { const int w = it >= T_DN; const int r = it - w * T_DN; const int kb = r / 64, nb = r % 64;
        transpose_item(a.in[w ? 23 : 8], DFF, D, (bf16_t*)(ws + (w ? WS_WDN2 : WS_WDN1)), 64 * kb, 32 * nb, 32 * nb, scr, lane); return; }
    it -= 2 * T_DN;
    if (it < T_IN) { const int kb = it / 161, nb = it % 161; transpose_item(a.in[10], D, DIN, (bf16_t*)(ws + WS_WIN), 64 * kb, 32 * nb, 32 * nb, scr, lane); return; }
    it -= T_IN;
    if (it < T_OUT) { const int kb = it / 64, nb = it % 64; transpose_item(a.in[20], D, D, (bf16_t*)(ws + WS_WOUT), 64 * kb, 32 * nb, 32 * nb, scr, lane); return; }
    it -= T_OUT;
    { const int mi = it >> 3, sub = it & 7, g = mi >> 4, d = (mi >> 3) & 1, n = mi & 7;
      transpose_item(a.in[g ? 16 : 14] + (size_t)(d * 8 + n) * 16384, 128, 128, (bf16_t*)(ws + WS_WG) + (size_t)((n * 2 + d) * 2 + g) * 16384, 64 * (sub >> 2), 32 * (sub & 3), 32 * (sub & 3), scr, lane); }
}
__device__ __forceinline__ void phase0(const Args& a, unsigned char* lds, int tid, int lane, int wave) {
    const int G = gridDim.x, bx = blockIdx.x;
    float* sc = (float*)lds;
    float* red = (float*)(lds + 24576);
    float* mod = (float*)(a.ws + WS_MOD);
    if (bx < 144) {
        for (int i = tid; i < 3 * D; i += NTHR) { const int r = i >> 11, k = i & 2047; const float c = r < 2 ? a.in[1][r * D + k] : a.in[3][k]; sc[i] = siluf_(c); }
        __syncthreads();
        for (int it = bx; it < 144; it += G) {
            const float* w = a.in[4] + (size_t)(wave * 256) * NMOD + it * 128 + 2 * lane;
            float a00 = 0.f, a01 = 0.f, a10 = 0.f, a11 = 0.f, a20 = 0.f, a21 = 0.f;
#pragma unroll 8
            for (int k = 0; k < 256; ++k) {
                const float2 wv = *(const float2*)(w + (size_t)k * NMOD);
                const float s0 = sc[wave * 256 + k], s1 = sc[D + wave * 256 + k], s2 = sc[2 * D + wave * 256 + k];
                a00 += s0 * wv.x; a01 += s0 * wv.y; a10 += s1 * wv.x; a11 += s1 * wv.y; a20 += s2 * wv.x; a21 += s2 * wv.y;
            }
            red[(wave * 6 + 0) * 64 + lane] = a00; red[(wave * 6 + 1) * 64 + lane] = a01; red[(wave * 6 + 2) * 64 + lane] = a10;
            red[(wave * 6 + 3) * 64 + lane] = a11; red[(wave * 6 + 4) * 64 + lane] = a20; red[(wave * 6 + 5) * 64 + lane] = a21;
            __syncthreads();
            if (tid < 384) { const int r = tid >> 7, cc = tid & 127; float s = a.in[5][it * 128 + cc];
#pragma unroll
                for (int w8 = 0; w8 < 8; ++w8) s += red[(w8 * 6 + r * 2 + (cc & 1)) * 64 + (cc >> 1)];
                mod[(size_t)r * NMOD + it * 128 + cc] = s; }
            __syncthreads();
        }
    }
    __syncthreads();
    { u32x4* z = (u32x4*)((bf16_t*)(a.ws + WS_WIN) + (size_t)DIN * D); const int nz = (DINP - DIN) * D / 8;
      for (int i = bx * NTHR + tid; i < nz; i += G * NTHR) z[i] = (u32x4){0u, 0u, 0u, 0u}; }
    float* scr = (float*)(lds + wave * 16384);
    if (G == 256) {
        const int start = bx < 144 ? 106 * bx : 144 * 106 + 232 * (bx - 144), cnt = bx < 144 ? 106 : 232;
        for (int i = wave; i < cnt; i += 8) p0_item(a, start + i, scr, lane);
    } else {
        for (int it = bx * 8 + wave; it < T_ALL; it += G * 8) p0_item(a, it, scr, lane);
    }
}
static_assert(144 * 106 + 112 * 232 == T_ALL, "phase-0 split");

__device__ __forceinline__ void norm_mod_rows(const float* srcL, const float* srcC, int nrows, const float* gnorm, const float* mod, int sub, bf16_t* XN, int gw, int NGW, int lane, const float* part = nullptr, const float* pgate = nullptr) {
    for (int m = gw; m < nrows; m += NGW) {
        const float* xr = m < ML ? srcL + (size_t)m * D : srcC + (size_t)(m - ML) * D;
        const int mr = m < ML ? (m >> 12) : 2;
        const float* sh = mod + (size_t)mr * NMOD + (3 * sub) * D; const float* scl = sh + D;
        f32x4 v[8]; float s = 0.f;
#pragma unroll
        for (int j = 0; j < 8; ++j) v[j] = ((const f32x4*)xr)[lane + 64 * j];
        if (part != nullptr && m >= ML) {
#pragma unroll
            for (int j = 0; j < 8; ++j) { f32x4 ps = {0.f, 0.f, 0.f, 0.f};
#pragma unroll
                for (int sp = 0; sp < NSPLIT; ++sp) ps += ((const f32x4*)(part + (size_t)sp * ((size_t)MC * D) + (size_t)(m - ML) * D))[lane + 64 * j];
                v[j] += ((const f32x4*)pgate)[lane + 64 * j] * 0.5f * ps; }
        }
#pragma unroll
        for (int j = 0; j < 8; ++j) s += (v[j].x * v[j].x + v[j].y * v[j].y) + (v[j].z * v[j].z + v[j].w * v[j].w);
        const float r = 1.0f / sqrtf(wave_sum(s) * (1.0f / D) + EPS);
        unsigned long long* o8 = (unsigned long long*)(XN + (size_t)m * D) + lane;
#pragma unroll
        for (int j = 0; j < 8; ++j) {
            const f32x4 g = ((const f32x4*)gnorm)[lane + 64 * j], shv = ((const f32x4*)sh)[lane + 64 * j], scv = ((const f32x4*)scl)[lane + 64 * j];
            const f32x4 y = (v[j] * r * g) * (scv + 1.0f) + shv;
            o8[64 * j] = (unsigned long long)pk2(y.x, y.y) | ((unsigned long long)pk2(y.z, y.w) << 32);
        }
    }
}
__device__ __forceinline__ void final_norm_rows(const float* X, const float* gnorm, float* out, int gw, int NGW, int lane) {
    for (int m = gw; m < ML; m += NGW) {
        const f32x4* xr = (const f32x4*)(X + (size_t)m * D) + lane;
        f32x4 v[8]; float s = 0.f;
#pragma unroll
        for (int j = 0; j < 8; ++j) { v[j] = xr[64 * j]; s += (v[j].x * v[j].x + v[j].y * v[j].y) + (v[j].z * v[j].z + v[j].w * v[j].w); }
        const float r = 1.0f / sqrtf(wave_sum(s) * (1.0f / D) + EPS);
        f32x4* o = (f32x4*)(out + (size_t)m * D) + lane;
#pragma unroll
        for (int j = 0; j < 8; ++j) { const f32x4 g = ((const f32x4*)gnorm)[lane + 64 * j]; o[64 * j] = v[j] * r * g; }
    }
}

__device__ __forceinline__ void lru_local_item(unsigned char* lds, int item, const Args& a, int tid, int lane, int wave) {
    const bf16_t* P = (const bf16_t*)(a.ws + WS_ACT);
    const bf16_t* WG = (const bf16_t*)(a.ws + WS_WG);
    bf16_t* HL = (bf16_t*)(a.ws + WS_HL); bf16_t* AC = (bf16_t*)(a.ws + WS_AC);
    float* CSUM = (float*)(a.ws + WS_CSUM);
    float* XC = (float*)lds;
    float* LA = (float*)(lds + 33792);
    float* LB = (float*)(lds + 67584);
    float* SEG = (float*)(lds + 101376);
    const int n = item & 7, sc = item >> 3;
    int b, ck, rowbase, seqlen, chunkidx; bool islat;
    if (sc < 128) { b = sc >> 6; ck = sc & 63; rowbase = b * SEQ; seqlen = SEQ; islat = true; chunkidx = 4 + ck; }
    else { const int s2 = sc - 128; b = s2 >> 2; ck = s2 & 3; rowbase = ML + b * CTXL; seqlen = CTXL; islat = false; chunkidx = ck; }
    const int t0 = ck * 64;
    {
        const int tok = tid >> 3, c8 = tid & 7, ch0 = n * 128 + c8 * 16;
        float accv[16];
#pragma unroll
        for (int i = 0; i < 16; i += 4) { const f32x4 bb = *(const f32x4*)(a.in[13] + ch0 + i); accv[i] = bb.x; accv[i + 1] = bb.y; accv[i + 2] = bb.z; accv[i + 3] = bb.w; }
#pragma unroll
        for (int k = 0; k < 4; ++k) {
            const int t = t0 + tok + k - 2;
            if (t >= 0 && t < seqlen) {
                const u32x4* src = (const u32x4*)(P + (size_t)(rowbase + t) * DINP + PC_LX + ch0);
                const u32x4 x0 = src[0], x1 = src[1];
                const float* cw = a.in[12] + k * 1024 + ch0;
                const unsigned xw[8] = {x0.x, x0.y, x0.z, x0.w, x1.x, x1.y, x1.z, x1.w};
#pragma unroll
                for (int i = 0; i < 8; ++i) { accv[2 * i] += cw[2 * i] * bflo(xw[i]); accv[2 * i + 1] += cw[2 * i + 1] * bfhi(xw[i]); }
            }
        }
#pragma unroll
        for (int i = 0; i < 16; i += 4) *(f32x4*)(XC + tok * 132 + c8 * 16 + i) = (f32x4){accv[i], accv[i + 1], accv[i + 2], accv[i + 3]};
    }
    __syncthreads();
    const int fr = lane & 15, fq = lane >> 4;
#pragma unroll 1
    for (int d = 0; d < 2; ++d) {
        {
            const int col = 16 * wave + fr, ch = n * 128 + col;
            const bf16_t* wg = WG + (size_t)((n * 2 + d) * 2) * 16384 + (size_t)col * 128 + fq * 8;
            bf16x8 Br[4], Bi[4];
#pragma unroll
            for (int ks = 0; ks < 4; ++ks) { Br[ks] = *(const bf16x8*)(wg + ks * 32); Bi[ks] = *(const bf16x8*)(wg + 16384 + ks * 32); }
            const float brv = a.in[15][d * 1024 + ch], biv = a.in[17][d * 1024 + ch];
            const float sp = log1pf(__expf(-a.in[18][d * 1024 + ch]));
#pragma unroll
            for (int m = 0; m < 4; ++m) {
                f32x4 ar = {0.f, 0.f, 0.f, 0.f}, ai = {0.f, 0.f, 0.f, 0.f};
#pragma unroll
                for (int ks = 0; ks < 4; ++ks) { const bf16x8 A = pack8(XC + (16 * m + fr) * 132 + ks * 32 + fq * 8); ar = MFMA16(A, Br[ks], ar); ai = MFMA16(A, Bi[ks], ai); }
#pragma unroll
                for (int j = 0; j < 4; ++j) {
                    const int tok = 16 * m + 4 * fq + j;
                    const float r = sigmoidf_(ar[j] + brv), ii = sigmoidf_(ai[j] + biv);
                    const float la = -8.0f * r * sp, av = __expf(la), mult = __builtin_amdgcn_sqrtf(neg_expm1f_(2.0f * la));
                    LA[tok * 132 + col] = av; LB[tok * 132 + col] = mult * ii * XC[tok * 132 + col];
                }
            }
        }
        __syncthreads();
        {
            const int seg = tid >> 7, ch = tid & 127;
            float hl[16], Al[16]; float h = 0.f, A = 1.f;
#pragma unroll
            for (int qi = 0; qi < 16; ++qi) { const int q = seg * 16 + qi, tok = d ? 63 - q : q; const float av = LA[tok * 132 + ch], bx = LB[tok * 132 + ch]; h = av * h + bx; A *= av; hl[qi] = h; Al[qi] = A; }
            SEG[(seg * 128 + ch) * 2] = A; SEG[(seg * 128 + ch) * 2 + 1] = h;
            __syncthreads();
            float carry = 0.f, Ap = 1.f;
#pragma unroll
            for (int s = 0; s < 3; ++s) if (s < seg) { const float As = SEG[(s * 128 + ch) * 2], hs = SEG[(s * 128 + ch) * 2 + 1]; carry = As * carry + hs; Ap *= As; }
            float Hlast = 0.f, Alast = 0.f;
#pragma unroll
            for (int qi = 0; qi < 16; ++qi) {
                const int q = seg * 16 + qi, tok = d ? 63 - q : q;
                const float H = hl[qi] + Al[qi] * carry, Ac = Al[qi] * Ap; Hlast = H; Alast = Ac;
                if (islat) { const size_t o = ((size_t)d * ML + rowbase + t0 + tok) * 1024 + n * 128 + ch; HL[o] = f2bf(H); AC[o] = f2bf(Ac); }
            }
            if (seg == 3) { const size_t o = ((size_t)((d * 2 + b) * 68 + chunkidx) * 2) * 1024 + n * 128 + ch; CSUM[o] = Alast; CSUM[o + 1024] = Hlast; }
        }
        __syncthreads();
    }
}

__device__ __forceinline__ void lru_carry(const Args& a, int gtid, int nthr) {
    const float* __restrict__ CSUM = (const float*)(a.ws + WS_CSUM);
    float* __restrict__ CARRY = (float*)(a.ws + WS_CARRY);
    for (int idx = gtid; idx < 4096; idx += nthr) {
        const int ch = idx & 1023, b = (idx >> 10) & 1, d = idx >> 11;
        const float* base = CSUM + (size_t)((d * 2 + b) * 68) * 2 * 1024 + ch;
        float carry = 0.f;
#pragma unroll 1
        for (int half = 0; half < 2; ++half) {
            float Av[34], hv[34];
#pragma unroll
            for (int s = 0; s < 34; ++s) { const int st = half * 34 + s; const int chunk = d == 0 ? st : (st < 4 ? 3 - st : 71 - st);
                Av[s] = base[(size_t)(chunk * 2) * 1024]; hv[s] = base[(size_t)(chunk * 2 + 1) * 1024]; }
#pragma unroll
            for (int s = 0; s < 34; ++s) { const int st = half * 34 + s; const int chunk = d == 0 ? st : (st < 4 ? 3 - st : 71 - st);
                if (chunk >= 4) CARRY[(size_t)((d * 2 + b) * 64 + (chunk - 4)) * 1024 + ch] = carry;
                carry = Av[s] * carry + hv[s]; }
        }
    }
}

__device__ __forceinline__ void lru_combine_rows(const Args& a, int gw, int NGW, int lane) {
    const bf16_t* P = (const bf16_t*)(a.ws + WS_ACT);
    const bf16_t* HL = (const bf16_t*)(a.ws + WS_HL); const bf16_t* AC = (const bf16_t*)(a.ws + WS_AC);
    const float* CARRY = (const float*)(a.ws + WS_CARRY);
    bf16_t* YA = (bf16_t*)(a.ws + WS_YA);
    for (int r = gw; r < ML; r += NGW) {
        const int b = r >> 12, ck = (r & 4095) >> 6;
#pragma unroll
        for (int jj = 0; jj < 2; ++jj) {
            const int ch = 8 * lane + 512 * jj;
            const u32x4 hf = *(const u32x4*)(HL + (size_t)r * 1024 + ch), af = *(const u32x4*)(AC + (size_t)r * 1024 + ch);
            const u32x4 hb = *(const u32x4*)(HL + ((size_t)ML + r) * 1024 + ch), ab = *(const u32x4*)(AC + ((size_t)ML + r) * 1024 + ch);
            const u32x4 lg = *(const u32x4*)(P + (size_t)r * DINP + PC_LG + ch);
            const float* cfp = CARRY + (size_t)((0 * 2 + b) * 64 + ck) * 1024 + ch; const float* cbp = CARRY + (size_t)((1 * 2 + b) * 64 + ck) * 1024 + ch;
            const f32x4 cf0 = *(const f32x4*)cfp, cf1 = *(const f32x4*)(cfp + 4), cb0 = *(const f32x4*)cbp, cb1 = *(const f32x4*)(cbp + 4);
            const float cf[8] = {cf0.x, cf0.y, cf0.z, cf0.w, cf1.x, cf1.y, cf1.z, cf1.w}, cb[8] = {cb0.x, cb0.y, cb0.z, cb0.w, cb1.x, cb1.y, cb1.z, cb1.w};
            const unsigned hfw[4] = {hf.x, hf.y, hf.z, hf.w}, afw[4] = {af.x, af.y, af.z, af.w}, hbw[4] = {hb.x, hb.y, hb.z, hb.w}, abw[4] = {ab.x, ab.y, ab.z, ab.w}, lgw[4] = {lg.x, lg.y, lg.z, lg.w};
            unsigned ow[4];
#pragma unroll
            for (int i = 0; i < 4; ++i) {
                const float r0 = bflo(hfw[i]) + bflo(afw[i]) * cf[2 * i] + bflo(hbw[i]) + bflo(abw[i]) * cb[2 * i];
                const float r1 = bfhi(hfw[i]) + bfhi(afw[i]) * cf[2 * i + 1] + bfhi(hbw[i]) + bfhi(abw[i]) * cb[2 * i + 1];
                ow[i] = pk2(gelu_tanhf_(bflo(lgw[i])) * r0, gelu_tanhf_(bfhi(lgw[i])) * r1);
            }
            *(u32x4*)(YA + (size_t)r * D + ch) = (u32x4){ow[0], ow[1], ow[2], ow[3]};
        }
    }
}

__device__ __forceinline__ int mrow_lat(int b, int p) { return b * SEQ + ((p & 63) << 6) + (p >> 6); }

__device__ __forceinline__ void mlstm_local_item(unsigned char* lds, int item, const Args& a, int tid, int lane, int wave) {
    const bf16_t* P = (const bf16_t*)(a.ws + WS_ACT);
    const float* Gt = (const float*)(a.ws + WS_G);
    float* CST = (float*)(a.ws + WS_CST); float* MSC = (float*)(a.ws + WS_MSC);
    bf16_t* VT = (bf16_t*)lds;
    bf16_t* KW = (bf16_t*)(lds + 34816);
    float* WGs = (float*)(lds + 69632);
    const int cidx = item % 34, bh = item / 34, h = bh & 7, b = bh >> 3;
    const int chain0 = (b * 8 + h) * 2;
#define MROW(j) (cidx < 2 ? ML + b * CTXL + cidx * 128 + (j) : mrow_lat(b, (cidx - 2) * 128 + (j)))
    if (wave < 2) {
        const int d = wave;
        const int j0 = d ? 127 - 2 * lane : 2 * lane, j1 = d ? 126 - 2 * lane : 2 * lane + 1;
        const float* g0p = Gt + (size_t)MROW(j0) * 32 + h; const float* g1p = Gt + (size_t)MROW(j1) * 32 + h;
        const float ig0 = g0p[(2 * d) * 8], fg0 = g0p[(2 * d + 1) * 8], ig1 = g1p[(2 * d) * 8], fg1 = g1p[(2 * d + 1) * 8];
        const float l0 = logsigmoidf_(fg0), l1 = logsigmoidf_(fg1);
        const float s1 = l0 + l1, incl = wave_incl_sum(s1, lane), excl = incl - s1, bc0 = excl + l0, bc1 = excl + s1;
        const float blast = __shfl(incl, 63);
        const float gg0 = blast - bc0 + ig0, gg1 = blast - bc1 + ig1;
        const float mloc = wave_max(fmaxf(gg0, gg1));
        WGs[d * 128 + j0] = __expf(gg0 - mloc); WGs[d * 128 + j1] = __expf(gg1 - mloc);
        if (lane == 0) { MSC[(size_t)((chain0 + d) * 34 + cidx) * 2] = mloc; MSC[(size_t)((chain0 + d) * 34 + cidx) * 2 + 1] = blast; }
    }
    const int j = tid & 127, q4 = tid >> 7; const size_t prow = (size_t)MROW(j) * DINP;
    {
        const u32x4* vs = (const u32x4*)(P + prow + PC_V + h * 128 + q4 * 32);
#pragma unroll
        for (int c = 0; c < 4; ++c) { const u32x4 x = vs[c]; const unsigned xw[4] = {x.x, x.y, x.z, x.w};
#pragma unroll
            for (int i = 0; i < 4; ++i) { VT[(q4 * 32 + c * 8 + 2 * i) * 136 + j] = (bf16_t)(xw[i] & 0xffffu); VT[(q4 * 32 + c * 8 + 2 * i + 1) * 136 + j] = (bf16_t)(xw[i] >> 16); } }
    }
    const u32x4* ks_ = (const u32x4*)(P + prow + PC_K + h * 64 + q4 * 16);
    const u32x4 k0 = ks_[0], k1 = ks_[1];
    __syncthreads();
    {
        const unsigned kw[8] = {k0.x, k0.y, k0.z, k0.w, k1.x, k1.y, k1.z, k1.w};
#pragma unroll
        for (int d = 0; d < 2; ++d) { const float w = WGs[d * 128 + j] * 0.125f;
#pragma unroll
            for (int i = 0; i < 8; ++i) { KW[(d * 64 + q4 * 16 + 2 * i) * 136 + j] = f2bf(bflo(kw[i]) * w); KW[(d * 64 + q4 * 16 + 2 * i + 1) * 136 + j] = f2bf(bfhi(kw[i]) * w); } }
    }
    __syncthreads();
    const int fr = lane & 15, fq = lane >> 4;
#pragma unroll
    for (int d = 0; d < 2; ++d) {
        f32x4 acc[4];
#pragma unroll
        for (int nt = 0; nt < 4; ++nt) acc[nt] = (f32x4){0.f, 0.f, 0.f, 0.f};
#pragma unroll
        for (int ks = 0; ks < 4; ++ks) {
            const bf16x8 A = *(const bf16x8*)(VT + (16 * wave + fr) * 136 + ks * 32 + fq * 8);
#pragma unroll
            for (int nt = 0; nt < 4; ++nt) { const bf16x8 B = *(const bf16x8*)(KW + (d * 64 + 16 * nt + fr) * 136 + ks * 32 + fq * 8); acc[nt] = MFMA16(A, B, acc[nt]); }
        }
        float* dst = CST + (size_t)((chain0 + d) * 34 + cidx) * CSTE;
#pragma unroll
        for (int nt = 0; nt < 4; ++nt)
#pragma unroll
            for (int i = 0; i < 4; ++i) dst[(16 * wave + 4 * fq + i) * 64 + 16 * nt + fr] = acc[nt][i];
    }
    if (tid < 128) { const int d = tid >> 6, k = tid & 63; float s = 0.f;
        for (int jj = 0; jj < 128; jj += 2) { const unsigned w = *(const unsigned*)(KW + (d * 64 + k) * 136 + jj); s += bflo(w) + bfhi(w); }
        CST[(size_t)((chain0 + d) * 34 + cidx) * CSTE + 8192 + k] = s; }
    __syncthreads();
#undef MROW
}

__device__ __forceinline__ void mlstm_state_scan(const Args& a, int gtid, int nthr) {
    const float* __restrict__ CST = (const float*)(a.ws + WS_CST);
    const float* __restrict__ MSC = (const float*)(a.ws + WS_MSC);
    float* __restrict__ CPREV = (float*)(a.ws + WS_CPREV);
    float* __restrict__ MPREV = (float*)(a.ws + WS_MSC + 65536);
    for (int idx = gtid; idx < 32 * (CSTE / 4); idx += nthr) {
        const int chain = idx / (CSTE / 4), e = (idx - chain * (CSTE / 4)) * 4, d = chain & 1;
        f32x4 val = {0.f, 0.f, 0.f, 0.f}; float m = 0.f;
#pragma unroll 1
        for (int half = 0; half < 2; ++half) {
            f32x4 tv[17];
#pragma unroll
            for (int s = 0; s < 17; ++s) { const int st = half * 17 + s; const int cidx = d == 0 ? st : (st < 2 ? 1 - st : 35 - st); tv[s] = *(const f32x4*)(CST + (size_t)(chain * 34 + cidx) * CSTE + e); }
#pragma unroll
            for (int s = 0; s < 17; ++s) {
                const int st = half * 17 + s; const int cidx = d == 0 ? st : (st < 2 ? 1 - st : 35 - st);
                const float mloc = MSC[(size_t)(chain * 34 + cidx) * 2], bl = MSC[(size_t)(chain * 34 + cidx) * 2 + 1];
                if (cidx >= 2) { *(f32x4*)(CPREV + (size_t)(chain * 32 + cidx - 2) * CSTE + e) = val; if (e == 0) MPREV[chain * 32 + cidx - 2] = m; }
                const float mn = fmaxf(bl + m, mloc);
                val = val * __expf(bl + m - mn) + tv[s] * __expf(mloc - mn); m = mn;
            }
        }
    }
}

__device__ __forceinline__ void mlstm_out_item(unsigned char* lds, int item, const Args& a, int tid, int lane, int wave) {
    const bf16_t* P = (const bf16_t*)(a.ws + WS_ACT);
    const float* Gt = (const float*)(a.ws + WS_G);
    const float* CPREV = (const float*)(a.ws + WS_CPREV); const float* MPREV = (const float*)(a.ws + WS_MSC + 65536);
    bf16_t* YA = (bf16_t*)(a.ws + WS_YA);
    bf16_t* Qs = (bf16_t*)lds;
    bf16_t* Ks = (bf16_t*)(lds + 18432);
    bf16_t* VT = (bf16_t*)(lds + 36864);
    bf16_t* Ws = (bf16_t*)(lds + 71680);
    bf16_t* Cs = (bf16_t*)(lds + 106496);
    float* BC = (float*)(lds + 127232);
    float* UU = (float*)(lds + 127232 + 1024);
    float* MM = (float*)(lds + 127232 + 2048);
    float* MP = (float*)(lds + 127232 + 3072);
    const int c = item & 31, bh = item >> 5, h = bh & 7, b = bh >> 3;
    const int chain0 = (b * 8 + h) * 2;
    if (wave < 2) {
        const int d = wave; const float mprev = MPREV[(chain0 + d) * 32 + c];
        const int j0 = d ? 127 - 2 * lane : 2 * lane, j1 = d ? 126 - 2 * lane : 2 * lane + 1;
        const float* g0p = Gt + (size_t)mrow_lat(b, c * 128 + j0) * 32 + h; const float* g1p = Gt + (size_t)mrow_lat(b, c * 128 + j1) * 32 + h;
        const float ig0 = g0p[(2 * d) * 8], fg0 = g0p[(2 * d + 1) * 8], ig1 = g1p[(2 * d) * 8], fg1 = g1p[(2 * d + 1) * 8];
        const float l0 = logsigmoidf_(fg0), l1 = logsigmoidf_(fg1);
        const float s1 = l0 + l1, incl = wave_incl_sum(s1, lane), excl = incl - s1, bc0 = excl + l0, bc1 = excl + s1;
        const float u0 = ig0 - bc0, u1 = ig1 - bc1;
        const float p1 = fmaxf(u0, u1), inclm = wave_incl_max(p1, lane);
        float exclm = __shfl_up(inclm, 1); if (lane == 0) exclm = -INFINITY;
        BC[d * 128 + j0] = bc0; BC[d * 128 + j1] = bc1; UU[d * 128 + j0] = u0; UU[d * 128 + j1] = u1;
        MM[d * 128 + j0] = fmaxf(mprev, fmaxf(exclm, u0)); MM[d * 128 + j1] = fmaxf(mprev, fmaxf(exclm, p1));
        if (lane == 0) MP[d] = mprev;
    }
    {
        const int j = tid & 127, q4 = tid >> 7; const size_t prow = (size_t)mrow_lat(b, c * 128 + j) * DINP;
        const u32x4* qs_ = (const u32x4*)(P + prow + PC_Q + h * 64 + q4 * 16);
        *(u32x4*)(Qs + j * 72 + q4 * 16) = qs_[0]; *(u32x4*)(Qs + j * 72 + q4 * 16 + 8) = qs_[1];
        const u32x4* ks_ = (const u32x4*)(P + prow + PC_K + h * 64 + q4 * 16);
#pragma unroll
        for (int cc = 0; cc < 2; ++cc) { const u32x4 x = ks_[cc]; u32x4 y;
            y.x = pk2(bflo(x.x) * 0.125f, bfhi(x.x) * 0.125f); y.y = pk2(bflo(x.y) * 0.125f, bfhi(x.y) * 0.125f); y.z = pk2(bflo(x.z) * 0.125f, bfhi(x.z) * 0.125f); y.w = pk2(bflo(x.w) * 0.125f, bfhi(x.w) * 0.125f);
            *(u32x4*)(Ks + j * 72 + q4 * 16 + cc * 8) = y; }
        const u32x4* vs = (const u32x4*)(P + prow + PC_V + h * 128 + q4 * 32);
#pragma unroll
        for (int cc = 0; cc < 4; ++cc) { const u32x4 x = vs[cc]; const unsigned xw[4] = {x.x, x.y, x.z, x.w};
#pragma unroll
            for (int i = 0; i < 4; ++i) { VT[(q4 * 32 + cc * 8 + 2 * i) * 136 + j] = (bf16_t)(xw[i] & 0xffffu); VT[(q4 * 32 + cc * 8 + 2 * i + 1) * 136 + j] = (bf16_t)(xw[i] >> 16); } }
    }
    for (int i = tid; i < 540; i += NTHR) ((unsigned*)(Cs + 129 * 72))[i] = 0u;
    __syncthreads();
    const int fr = lane & 15, fq = lane >> 4, trow = 16 * wave + 4 * fq;
    f32x4 S[8];
#pragma unroll
    for (int nt = 0; nt < 8; ++nt) S[nt] = (f32x4){0.f, 0.f, 0.f, 0.f};
#pragma unroll
    for (int ks = 0; ks < 2; ++ks) {
        const bf16x8 A = *(const bf16x8*)(Qs + (16 * wave + fr) * 72 + ks * 32 + fq * 8);
#pragma unroll
        for (int nt = 0; nt < 8; ++nt) { const bf16x8 B = *(const bf16x8*)(Ks + (16 * nt + fr) * 72 + ks * 32 + fq * 8); S[nt] = MFMA16(A, B, S[nt]); }
    }
    f32x4 hsum[8];
#pragma unroll
    for (int nt = 0; nt < 8; ++nt) hsum[nt] = (f32x4){0.f, 0.f, 0.f, 0.f};
#pragma unroll 1
    for (int d = 0; d < 2; ++d) {
        { const f32x4* src = (const f32x4*)(CPREV + (size_t)((chain0 + d) * 32 + c) * CSTE);
          for (int i = tid; i < CSTE / 4; i += NTHR) { const f32x4 x = src[i]; const int e = i * 4, v = e >> 6, k = e & 63;
              *(unsigned long long*)(Cs + v * 72 + k) = (unsigned long long)pk2(x.x, x.y) | ((unsigned long long)pk2(x.z, x.w) << 32); } }
        float Mt[4], den2[4];
#pragma unroll
        for (int i = 0; i < 4; ++i) { Mt[i] = MM[d * 128 + trow + i]; den2[i] = 0.f; }
#pragma unroll
        for (int nt = 0; nt < 8; ++nt) {
            const int s = 16 * nt + fr; const float us = UU[d * 128 + s];
#pragma unroll
            for (int i = 0; i < 4; ++i) { const int t = trow + i; const bool ok = d ? (s >= t) : (s <= t);
                const float wv = ok ? S[nt][i] * __expf(us - Mt[i]) : 0.f; den2[i] += wv; Ws[t * 136 + s] = f2bf(wv); }
        }
#pragma unroll
        for (int i = 0; i < 4; ++i) { float v = den2[i]; v += __shfl_xor(v, 1); v += __shfl_xor(v, 2); v += __shfl_xor(v, 4); v += __shfl_xor(v, 8); den2[i] = v; }
        __syncthreads();
        f32x4 O[9];
#pragma unroll
        for (int nt = 0; nt < 9; ++nt) O[nt] = (f32x4){0.f, 0.f, 0.f, 0.f};
#pragma unroll
        for (int ks = 0; ks < 2; ++ks) {
            const bf16x8 A = *(const bf16x8*)(Qs + (16 * wave + fr) * 72 + ks * 32 + fq * 8);
#pragma unroll
            for (int nt = 0; nt < 9; ++nt) { const bf16x8 B = *(const bf16x8*)(Cs + (16 * nt + fr) * 72 + ks * 32 + fq * 8); O[nt] = MFMA16(A, B, O[nt]); }
        }
        const float mprev = MP[d];
        float si[4], den1[4];
#pragma unroll
        for (int i = 0; i < 4; ++i) { si[i] = __expf(mprev - Mt[i]); den1[i] = __shfl(O[8][i], lane & 48); }
#pragma unroll
        for (int nt = 0; nt < 8; ++nt)
#pragma unroll
            for (int i = 0; i < 4; ++i) O[nt][i] *= si[i];
#pragma unroll
        for (int ks = 0; ks < 4; ++ks) {
            const bf16x8 A = *(const bf16x8*)(Ws + (16 * wave + fr) * 136 + ks * 32 + fq * 8);
#pragma unroll
            for (int nt = 0; nt < 8; ++nt) { const bf16x8 B = *(const bf16x8*)(VT + (16 * nt + fr) * 136 + ks * 32 + fq * 8); O[nt] = MFMA16(A, B, O[nt]); }
        }
#pragma unroll
        for (int i = 0; i < 4; ++i) {
            const float den = si[i] * den1[i] + den2[i];
            const float dn = fmaxf(fabsf(den), __expf(-(BC[d * 128 + trow + i] + Mt[i])));
            const float inv = 1.0f / dn;
#pragma unroll
            for (int nt = 0; nt < 8; ++nt) hsum[nt][i] += O[nt][i] * inv;
        }
        __syncthreads();
    }
    const float* gain = a.in[19] + h * 128;
#pragma unroll
    for (int i = 0; i < 4; ++i) {
        float ss = 0.f;
#pragma unroll
        for (int nt = 0; nt < 8; ++nt) ss += hsum[nt][i] * hsum[nt][i];
        ss += __shfl_xor(ss, 1); ss += __shfl_xor(ss, 2); ss += __shfl_xor(ss, 4); ss += __shfl_xor(ss, 8);
        const float rinv = 1.0f / sqrtf(ss * (1.0f / 128.0f) + EPS);
        const size_t row = (size_t)mrow_lat(b, c * 128 + trow + i);
#pragma unroll
        for (int nt = 0; nt < 8; ++nt) { const int v = 16 * nt + fr;
            const float o = bf2f(P[row * DINP + PC_O + h * 128 + v]);
            YA[row * D + 1024 + h * 128 + v] = f2bf(hsum[nt][i] * rinv * gain[v] * sigmoidf_(o)); }
    }
    __syncthreads();
}

#ifndef PROBE
#define PROBE 0
#endif
#ifndef STAGE
#define STAGE 99
#endif
__global__ void __launch_bounds__(NTHR, 2) mega(Args a) {
    extern __shared__ __attribute__((aligned(16))) unsigned char lds[];
    cg::grid_group grid = cg::this_grid();
    const int tid = threadIdx.x, lane = tid & 63, wave = __builtin_amdgcn_readfirstlane(tid >> 6);
    const int G = gridDim.x, gw = blockIdx.x * 8 + wave, NGW = G * 8;
    unsigned char* ws = a.ws;
    float* mod = (float*)(ws + WS_MOD);
    bf16_t* XN = (bf16_t*)(ws + WS_XN);
    bf16_t* ACT = (bf16_t*)(ws + WS_ACT);
    bf16_t* P = (bf16_t*)(ws + WS_ACT);
    float* X = (float*)(ws + WS_X);
    PG8_LAS unsigned char* ldsl = (PG8_LAS unsigned char*)lds;
    volatile LAS unsigned* MISC = (volatile LAS unsigned*)(ldsl + (LDS_BYTES - 64));
    if (tid < 16) MISC[tid] = 0u;
    __syncthreads();
    const XcdBarrier xbar = xcd_barrier_post((unsigned*)(ws + WS_BAR), MISC + 8);
    if (a.never) grid.sync();
#define GSYNC() xcd_barrier(xbar)

    phase0(a, lds, tid, lane, wave);
    GSYNC();
#if PROBE == 6
    for (int i = 0; i < 10; ++i) GSYNC();
#endif
#if PROBE == 1
    phase0(a, lds, tid, lane, wave);
    GSYNC();
#endif
    norm_mod_rows(a.in[0], a.in[2], MT, a.in[6], mod, 0, XN, gw, NGW, lane);
    GSYNC();
    { pg8::Gemm g{XN, (const bf16_t*)(ws + WS_WUP1), MT, 2 * DFF, D, D}; pg8::StaticOrder S; S.init(MT, 2 * DFF, G, (int)blockIdx.x);
      EpiSwiglu E{ACT, DFF}; pg8::gemm_phase<EpiSwiglu, pg8::StaticOrder, true, true>(ldsl, g, S, E); }
    GSYNC();
#if PROBE == 2
    { pg8::Gemm g{XN, (const bf16_t*)(ws + WS_WUP1), MT, 2 * DFF, D, D}; pg8::StaticOrder S; S.init(MT, 2 * DFF, G, (int)blockIdx.x);
      EpiSwiglu E{ACT, DFF}; pg8::gemm_phase<EpiSwiglu, pg8::StaticOrder, true, true>(ldsl, g, S, E); }
    GSYNC();
#endif
    { pg8::Gemm g{ACT, (const bf16_t*)(ws + WS_WDN1), ML, D, DFF, DFF}; pg8::StaticOrder S; S.init(ML, D, G, (int)blockIdx.x);
      EpiResid E{a.in[0], a.in[2], X, mod, 2 * D, 0.5f, nullptr}; pg8::gemm_phase<EpiResid, pg8::StaticOrder, true, true>(ldsl, g, S, E); }
    { pg8::Gemm g{ACT, (const bf16_t*)(ws + WS_WDN1), MT, D, KSPLIT, DFF}; SplitOrder S; S.init(G, (int)blockIdx.x);
      EpiResid E{a.in[0], a.in[2], X, mod, 2 * D, 0.5f, (float*)(ws + WS_HL)}; pg8::gemm_phase<EpiResid, SplitOrder, true, true>(ldsl, g, S, E); }
    GSYNC();
#if STAGE >= 2
    norm_mod_rows(X, a.in[2], MT, a.in[9], mod, 1, XN, gw, NGW, lane, (const float*)(ws + WS_HL), mod + (size_t)2 * NMOD + 2 * D);
    GSYNC();
    { pg8::Gemm g{XN, (const bf16_t*)(ws + WS_WIN), MT, DINP, D, D}; pg8::StaticOrder S; S.init(MT, DINP, G, (int)blockIdx.x);
      EpiInProj E{P, (float*)(ws + WS_G), a.in[11]}; pg8::gemm_phase<EpiInProj, pg8::StaticOrder, true, true>(ldsl, g, S, E); }
    GSYNC();
    for (int it = blockIdx.x; it < 1088 + 544; it += G) {
        if (it < 1088) lru_local_item(lds, it, a, tid, lane, wave);
        else mlstm_local_item(lds, it - 1088, a, tid, lane, wave);
    }
    GSYNC();
    lru_carry(a, blockIdx.x * NTHR + tid, G * NTHR);
    mlstm_state_scan(a, blockIdx.x * NTHR + tid, G * NTHR);
    GSYNC();
    for (int it = blockIdx.x; it < 512; it += G) mlstm_out_item(lds, it, a, tid, lane, wave);
    lru_combine_rows(a, gw, NGW, lane);
    GSYNC();
#if PROBE == 7
    for (int it = blockIdx.x; it < 1088; it += G) lru_local_item(lds, it, a, tid, lane, wave);
    GSYNC();
#endif
#if PROBE == 8
    for (int it = blockIdx.x; it < 544; it += G) mlstm_local_item(lds, it, a, tid, lane, wave);
    GSYNC();
#endif
#if PROBE == 9
    for (int it = blockIdx.x; it < 512; it += G) mlstm_out_item(lds, it, a, tid, lane, wave);
    GSYNC();
#endif
#if PROBE == 12
    mlstm_state_scan(a, blockIdx.x * NTHR + tid, G * NTHR);
    GSYNC();
#endif
#if PROBE == 3
    for (int it = blockIdx.x; it < 1088 + 544; it += G) {
        if (it < 1088) lru_local_item(lds, it, a, tid, lane, wave);
        else mlstm_local_item(lds, it - 1088, a, tid, lane, wave);
    }
    GSYNC();
#endif
#if PROBE == 4
    lru_carry(a, blockIdx.x * NTHR + tid, G * NTHR);
    mlstm_state_scan(a, blockIdx.x * NTHR + tid, G * NTHR);
    GSYNC();
#endif
#if PROBE == 5
    for (int it = blockIdx.x; it < 512; it += G) mlstm_out_item(lds, it, a, tid, lane, wave);
    lru_combine_rows(a, gw, NGW, lane);
    GSYNC();
#endif
    { pg8::Gemm g{(const bf16_t*)(ws + WS_YA), (const bf16_t*)(ws + WS_WOUT), ML, D, D, D}; pg8::StaticOrder S; S.init(ML, D, G, (int)blockIdx.x);
      EpiResid E{X, X, X, mod, 5 * D, 1.0f, nullptr}; pg8::gemm_phase<EpiResid, pg8::StaticOrder, true, true>(ldsl, g, S, E); }
    GSYNC();
#endif
#if STAGE >= 3
    norm_mod_rows(X, X, ML, a.in[21], mod, 2, XN, gw, NGW, lane);
    GSYNC();
    { pg8::Gemm g{XN, (const bf16_t*)(ws + WS_WUP2), ML, 2 * DFF, D, D}; pg8::StaticOrder S; S.init(ML, 2 * DFF, G, (int)blockIdx.x);
      EpiSwiglu E{ACT, DFF}; pg8::gemm_phase<EpiSwiglu, pg8::StaticOrder, true, true>(ldsl, g, S, E); }
    GSYNC();
    { pg8::Gemm g{ACT, (const bf16_t*)(ws + WS_WDN2), ML, D, DFF, DFF}; pg8::StaticOrder S; S.init(ML, D, G, (int)blockIdx.x);
      EpiResid E{X, X, X, mod, 8 * D, 0.5f, nullptr}; pg8::gemm_phase<EpiResid, pg8::StaticOrder, true, true>(ldsl, g, S, E); }
    GSYNC();
#endif
    final_norm_rows(X, a.in[24], a.out, gw, NGW, lane);
}

extern "C" void kernel_launch(void* const* d_in, const int* in_sizes, int n_in, void* d_out, int out_size, void* d_ws, size_t ws_size, hipStream_t stream) {
    static int grid = 0;
    if (grid == 0) {
        if (n_in != 25 || out_size != ML * D || ws_size < WS_END) { fprintf(stderr, "kernel_launch: unexpected shapes (n_in %d out %d ws %zu)\n", n_in, out_size, ws_size); grid = -1; return; }
        int dev = 0, cus = 0, per_cu = 0;
        hipGetDevice(&dev);
        hipDeviceGetAttribute(&cus, hipDeviceAttributeMultiprocessorCount, dev);
        hipFuncSetAttribute((const void*)mega, hipFuncAttributeMaxDynamicSharedMemorySize, LDS_BYTES);
        hipOccupancyMaxActiveBlocksPerMultiprocessor(&per_cu, (const void*)mega, NTHR, LDS_BYTES);
        if (per_cu < 1) fprintf(stderr, "kernel_launch: occupancy query says %d blocks per CU\n", per_cu);
        (void)hipGetLastError();
        grid = cus;
    }
    if (grid < 0) return;
    if (hipMemsetAsync((char*)d_ws + WS_BAR, 0, 16384, stream) != hipSuccess) { fprintf(stderr, "kernel_launch: memset of the barrier words failed\n"); return; }
    Args a{};
    for (int i = 0; i < 25; ++i) a.in[i] = (const float*)d_in[i];
    a.out = (float*)d_out; a.ws = (unsigned char*)d_ws;
    void* args[] = {&a};
    hipError_t e = hipLaunchCooperativeKernel((const void*)mega, dim3(grid), dim3(NTHR), args, LDS_BYTES, stream);
    if (e != hipSuccess) fprintf(stderr, "cooperative launch failed: %s (grid %d)\n", hipGetErrorString(e), grid);
}
```
